# Optimizing an MI355X kernel written in HIP

```python
import numpy as np
import jax, jax.numpy as jnp
from jax import lax

D_MODEL = 1024
BATCH = 32
SEQ = 256
DEPTH = 1
DEC_BATCH = 2
DEC_SEQ = 2048
PAST_LEN = 256

GRID_W = 64
GLA_HEADS = 4
GLA_DK = 64
GLA_DV = 128
GLA_LOWRANK = 16
GLA_GATE_NORM = 16.0
GLA_CHUNK = 64
ATT_HEADS = 8
ATT_KV_HEADS = 2
HEAD_DIM = 64
ROPE_AXIS_DIM = HEAD_DIM // 2
ROPE_THETA = 10000.0
Q_BLOCK = 128
D_FF = -(-8 * D_MODEL // (3 * 256)) * 256
N_MOD = 6
EPS = 1e-6
SPLIT_SIZES = (GLA_HEADS * GLA_DK, GLA_HEADS * GLA_DK, GLA_HEADS * GLA_DV, GLA_HEADS * GLA_DV,
               2 * GLA_LOWRANK, ATT_HEADS * HEAD_DIM, ATT_KV_HEADS * HEAD_DIM, ATT_KV_HEADS * HEAD_DIM)
D_IN_PROJ = sum(SPLIT_SIZES)
D_MIX = GLA_HEADS * GLA_DV + ATT_HEADS * HEAD_DIM

kernel_name = 'hybrid_gla_gqa_prefix_dit_step'

F32 = jnp.float32


def rms_norm(x, g):
    xf = x.astype(F32)
    y = xf * lax.rsqrt(jnp.mean(xf * xf, axis=-1, keepdims=True) + EPS)
    return (y * g.astype(F32)).astype(x.dtype)


def adaln_params(cond, ada_w, ada_b):
    mod = jax.nn.silu(cond) @ ada_w + ada_b
    return jnp.split(mod, N_MOD, axis=-1)


def modulate(h, shift, scale):
    return h * (1.0 + scale[:, None, :]) + shift[:, None, :]


def axial_rope_tables(T):
    rows = T // GRID_W
    row = jnp.repeat(jnp.arange(rows, dtype=F32), GRID_W)
    col = jnp.tile(jnp.arange(GRID_W, dtype=F32), rows)
    inv = ROPE_THETA ** (-jnp.arange(0, ROPE_AXIS_DIM, 2, dtype=F32) / ROPE_AXIS_DIM)
    ang = jnp.stack([row[:, None] * inv, col[:, None] * inv], axis=1)
    return jnp.cos(ang), jnp.sin(ang)


def apply_axial_rope(x, cos, sin):
    B, T, H, Dh = x.shape
    xr = x.reshape(B, T, H, 2, 2, ROPE_AXIS_DIM // 2).astype(F32)
    x1, x2 = xr[..., 0, :], xr[..., 1, :]
    c, s = cos[None, :, None], sin[None, :, None]
    out = jnp.stack([x1 * c - x2 * s, x1 * s + x2 * c], axis=-2)
    return out.reshape(B, T, H, Dh).astype(x.dtype)


def gla_chunked(q, k, v, g, s0):
    B, T, H, DK = q.shape
    DV = v.shape[-1]
    n = T // GLA_CHUNK
    q = q.astype(F32).reshape(B, n, GLA_CHUNK, H, DK) * (DK ** -0.5)
    k = k.astype(F32).reshape(B, n, GLA_CHUNK, H, DK)
    v = v.astype(F32).reshape(B, n, GLA_CHUNK, H, DV)
    b = jnp.cumsum(g.astype(F32).reshape(B, n, GLA_CHUNK, H, DK), axis=2)
    b_last = b[:, :, -1:]
    q_t = q * jnp.exp(b)
    k_t = k * jnp.exp(-b)
    k_e = k * jnp.exp(b_last - b)
    mask = jnp.tril(jnp.ones((GLA_CHUNK, GLA_CHUNK), dtype=bool))
    a = jnp.where(mask, jnp.einsum('bnihd,bnjhd->bnhij', q_t, k_t), 0.0)
    o_intra = jnp.einsum('bnhij,bnjhv->bnihv', a, v)
    u = jnp.einsum('bnjhd,bnjhv->bnhdv', k_e, v)
    decay = jnp.exp(b_last[:, :, 0])

    def step(s, inp):
        d, uu = inp
        return d[..., None] * s + uu, s

    s_fin, s_prev = lax.scan(step, s0.astype(F32), (jnp.moveaxis(decay, 1, 0), jnp.moveaxis(u, 1, 0)))
    s_prev = jnp.moveaxis(s_prev, 0, 1)
    o_inter = jnp.einsum('bnihd,bnhdv->bnihv', q_t, s_prev)
    return (o_intra + o_inter).reshape(B, T, H, DV), s_fin


def blocked_attention(q, k, v):
    B, T, H, Dh = q.shape
    Hkv = k.shape[2]
    G = H // Hkv
    nb = T // Q_BLOCK
    qb = jnp.moveaxis(q.reshape(B, nb, Q_BLOCK, Hkv, G, Dh), 1, 0) * (Dh ** -0.5)

    def one_block(qi):
        s = jnp.einsum('bqhgd,bkhd->bhgqk', qi.astype(F32), k.astype(F32))
        p = jax.nn.softmax(s, axis=-1)
        return jnp.einsum('bhgqk,bkhd->bqhgd', p, v.astype(F32))

    o = lax.map(one_block, qb)
    return jnp.moveaxis(o, 0, 1).reshape(B, T, H * Dh).astype(q.dtype)


def mixer(h, rope, ctx_kv, s_f0, s_b0, w_in, w_gk2, b_gk2, gla_g, q_g, k_g, w_out):
    B, T, _ = h.shape
    offs = np.cumsum(SPLIT_SIZES)[:-1].tolist()
    qg, kg, vg, og, lr, qa, ka, va = jnp.split(h @ w_in, offs, axis=-1)
    qg = qg.reshape(B, T, GLA_HEADS, GLA_DK)
    kg = kg.reshape(B, T, GLA_HEADS, GLA_DK)
    vg = vg.reshape(B, T, GLA_HEADS, GLA_DV)
    gk = jnp.einsum('btrl,rlk->btrk', lr.reshape(B, T, 2, GLA_LOWRANK), w_gk2) + b_gk2
    gk = (jax.nn.log_sigmoid(gk.astype(F32)) / GLA_GATE_NORM).reshape(B, T, 2, GLA_HEADS, GLA_DK)
    o_f, s_f = gla_chunked(qg, kg, vg, gk[:, :, 0], s_f0)
    o_b, s_b = gla_chunked(qg[:, ::-1], kg[:, ::-1], vg[:, ::-1], gk[:, ::-1, 1], s_b0)
    o_gla = rms_norm(o_f + o_b[:, ::-1], gla_g).astype(h.dtype)
    o_gla = (o_gla * jax.nn.silu(og.reshape(B, T, GLA_HEADS, GLA_DV))).reshape(B, T, GLA_HEADS * GLA_DV)
    qa = rms_norm(qa.reshape(B, T, ATT_HEADS, HEAD_DIM), q_g)
    ka = rms_norm(ka.reshape(B, T, ATT_KV_HEADS, HEAD_DIM), k_g)
    va = va.reshape(B, T, ATT_KV_HEADS, HEAD_DIM)
    if rope is None:
        keys, vals = ka, va
    else:
        qa = apply_axial_rope(qa, *rope)
        ka = apply_axial_rope(ka, *rope)
        ck, cv = ctx_kv
        keys = jnp.concatenate([ka, ck.astype(ka.dtype)], axis=1)
        vals = jnp.concatenate([va, cv.astype(va.dtype)], axis=1)
    o_att = blocked_attention(qa, keys, vals)
    out = jnp.concatenate([o_gla, o_att], axis=-1) @ w_out
    return out, ka, va, s_f, s_b


def swiglu(h, w1, w3, w2):
    return (jax.nn.silu(h @ w1) * (h @ w3)) @ w2


def block(x, cond, rope, ctx_kv, s_f0, s_b0, ada_w, ada_b, n1, n2, w_in, w_gk2, b_gk2,
          gla_g, q_g, k_g, w_out, w1, w3, w2):
    sh1, sc1, g1, sh2, sc2, g2 = adaln_params(cond, ada_w, ada_b)
    h = modulate(rms_norm(x, n1), sh1, sc1)
    out, k, v, s_f, s_b = mixer(h, rope, ctx_kv, s_f0, s_b0, w_in, w_gk2, b_gk2, gla_g, q_g, k_g, w_out)
    x = x + g1[:, None, :] * out
    h = modulate(rms_norm(x, n2), sh2, sc2)
    x = x + g2[:, None, :] * swiglu(h, w1, w3, w2)
    return x, k, v, s_f, s_b


def setup_inputs(seed: int = 0) -> dict:
    key = jax.random.key(seed)
    ks = jax.random.split(key, 24)
    nrm = jax.random.normal
    D = D_MODEL
    return {
        'x_prompt': nrm(ks[0], (BATCH, SEQ, D), F32),
        'x_sample': nrm(ks[1], (DEC_BATCH, DEC_SEQ, D), F32),
        'cache_k': nrm(ks[2], (DEC_BATCH, DEPTH, PAST_LEN, ATT_KV_HEADS, HEAD_DIM), F32),
        'cache_v': nrm(ks[3], (DEC_BATCH, DEPTH, PAST_LEN, ATT_KV_HEADS, HEAD_DIM), F32),
        'state_gla_fwd': nrm(ks[4], (DEC_BATCH, DEPTH, GLA_HEADS, GLA_DK, GLA_DV), F32),
        'state_gla_bwd': nrm(ks[5], (DEC_BATCH, DEPTH, GLA_HEADS, GLA_DK, GLA_DV), F32),
        'c': nrm(ks[6], (DEC_BATCH, D), F32),
        'c_ctx': nrm(ks[7], (D,), F32),
        'ada_w': nrm(ks[8], (DEPTH, D, N_MOD * D), F32) * D ** -0.5,
        'ada_b': nrm(ks[9], (DEPTH, N_MOD * D), F32) * 0.02,
        'norm1_g': 1.0 + 0.02 * nrm(ks[10], (DEPTH, D), F32),
        'norm2_g': 1.0 + 0.02 * nrm(ks[11], (DEPTH, D), F32),
        'w_in': nrm(ks[12], (DEPTH, D, D_IN_PROJ), F32) * D ** -0.5,
        'w_gk2': nrm(ks[13], (DEPTH, 2, GLA_LOWRANK, GLA_HEADS * GLA_DK), F32) * GLA_LOWRANK ** -0.5,
        'b_gk2': nrm(ks[14], (DEPTH, 2, GLA_HEADS * GLA_DK), F32) * 0.1,
        'gla_norm_g': 1.0 + 0.02 * nrm(ks[15], (DEPTH, GLA_DV), F32),
        'q_norm_g': 1.0 + 0.02 * nrm(ks[16], (DEPTH, HEAD_DIM), F32),
        'k_norm_g': 1.0 + 0.02 * nrm(ks[17], (DEPTH, HEAD_DIM), F32),
        'w_out': nrm(ks[18], (DEPTH, D_MIX, D), F32) * D_MIX ** -0.5,
        'w_ffn1': nrm(ks[19], (DEPTH, D, D_FF), F32) * D ** -0.5,
        'w_ffn3': nrm(ks[20], (DEPTH, D, D_FF), F32) * D ** -0.5,
        'w_ffn2': nrm(ks[21], (DEPTH, D_FF, D), F32) * D_FF ** -0.5,
        'final_g': 1.0 + 0.02 * nrm(ks[22], (D,), F32),
    }


def reference(x_prompt, x_sample, cache_k, cache_v, state_gla_fwd, state_gla_bwd, c, c_ctx,
              ada_w, ada_b, norm1_g, norm2_g, w_in, w_gk2, b_gk2, gla_norm_g, q_norm_g, k_norm_g,
              w_out, w_ffn1, w_ffn3, w_ffn2, final_g):
    B = x_prompt.shape[0]
    T = x_sample.shape[1]
    rope = axial_rope_tables(T)
    zero_state = jnp.zeros((B, GLA_HEADS, GLA_DK, GLA_DV), F32)
    cond_ctx = jnp.broadcast_to(c_ctx[None, :], (B, D_MODEL))
    xc, xl = x_prompt, x_sample
    ks_new, vs_new, sf_new, sb_new = [], [], [], []
    for l in range(DEPTH):
        lw = (ada_w[l], ada_b[l], norm1_g[l], norm2_g[l], w_in[l], w_gk2[l], b_gk2[l],
              gla_norm_g[l], q_norm_g[l], k_norm_g[l], w_out[l], w_ffn1[l], w_ffn3[l], w_ffn2[l])
        xc, k_c, v_c, s_f, s_b = block(xc, cond_ctx, None, None, zero_state, zero_state, *lw)
        ks_new.append(k_c)
        vs_new.append(v_c)
        sf_new.append(s_f)
        sb_new.append(s_b)
        xl, _, _, _, _ = block(xl, c, rope, (cache_k[:, l], cache_v[:, l]),
                               state_gla_fwd[:, l], state_gla_bwd[:, l], *lw)
    y_prompt = rms_norm(xc, final_g)
    y_sample = rms_norm(xl, final_g)
    new_cache_k = jnp.stack(ks_new, axis=1)
    new_cache_v = jnp.stack(vs_new, axis=1)
    new_state_gla_fwd = jnp.stack(sf_new, axis=1)
    new_state_gla_bwd = jnp.stack(sb_new, axis=1)
    return (y_prompt, y_sample, new_cache_k, new_cache_v, new_state_gla_fwd, new_state_gla_bwd)
```

```cpp
#include <hip/hip_runtime.h>
#include <hip/hip_cooperative_groups.h>
#include <hip/hip_bf16.h>
#include <cstdio>
#include <cstdint>
#include <cmath>
namespace cg = cooperative_groups;
namespace pg8 {
#define PG8_LAS __attribute__((address_space(3)))
typedef unsigned short bf16_t;
typedef short bf16x8 __attribute__((ext_vector_type(8)));
typedef float f32x4 __attribute__((ext_vector_type(4)));
typedef unsigned u32x4 __attribute__((ext_vector_type(4)));
constexpr int BM = 256, BK = 64, HALF = 128, HTB = HALF * BK * 2  , STAGE_BYTES = 8 * HTB, NXCD = 8, WGM = 8;

__host__ __device__ __forceinline__ int lds_byte(int r, int c) { const int st = (r >> 4) * 2 + (c >> 5), rr = r & 15, cc = c & 31, ob = rr * 64 + cc * 2; return st * 1024 + (ob ^ (((ob >> 9) & 1) << 5)); }
__host__ __device__ __forceinline__ void stage_rc(int b, int& R, int& C) { const int st = b / 1024, sb = b % 1024, swz = sb ^ (((sb >> 9) & 1) << 5); R = (st >> 1) * 16 + swz / 64; C = (st & 1) * 32 + (swz % 64) / 2; }
__host__ __device__ __forceinline__ int perm32(int rho) { const int n = rho >> 4, i = rho & 15; return 8 * (i >> 2) + 4 * n + (i & 3); }

struct Unit { int pm, pn; };
struct Gemm { const bf16_t* A; const bf16_t* Bt; int M, N, K; };

struct StaticOrder {
    int nM, nN, nwg, G, c;
    __host__ __device__ void init(int M, int N, int G_, int c_) { nM = M / BM; nN = N / BM; nwg = nM * nN; G = G_; c = c_; }
    __host__ __device__ bool next(int i, Unit& u) const {
        const long L = (long)i * G + c; if (L >= nwg) return false;
        int wgid = (int)L; { const int q = nwg / NXCD, r = nwg % NXCD, xcd = wgid % NXCD, off = wgid / NXCD; wgid = (xcd < r ? xcd * (q + 1) : r * (q + 1) + (xcd - r) * q) + off; }
        const int nig = WGM * nN, gid = wgid / nig, fm = gid * WGM, gsz = (nM - fm) < WGM ? (nM - fm) : WGM;
        u.pm = fm + ((wgid % nig) % gsz); u.pn = (wgid % nig) / gsz; return true;
    }
    __device__ __forceinline__ void a_ready(const Unit&) const {}
    __device__ __forceinline__ void done(const Unit&) const {}
};

__device__ __forceinline__ unsigned cvt_pk_bf16(float lo, float hi) { unsigned r; asm volatile("v_cvt_pk_bf16_f32 %0, %1, %2" : "=v"(r) : "v"(lo), "v"(hi)); return r; }
struct EpiStore {
    static constexpr bool PERM = true, AFTER_DRAIN = false;
    bf16_t* O; int ldc;
    __device__ __forceinline__ void operator()(const f32x4 (&acc)[2][2][4][2], const Unit& u, int wr, int wc, int fr, int fq) const {
        const int row0 = u.pm * BM + wr * 64 + fr, col0 = u.pn * BM + wc * 32 + 8 * fq;
#pragma unroll
        for (int ai = 0; ai < 2; ++ai)
#pragma unroll
            for (int m = 0; m < 4; ++m) { bf16_t* rowp = O + (size_t)(row0 + ai * HALF + m * 16) * ldc + col0;
#pragma unroll
                for (int bj = 0; bj < 2; ++bj) { const f32x4 v0 = acc[ai][bj][m][0], v1 = acc[ai][bj][m][1];
                    u32x4 w; w.x = cvt_pk_bf16(v0[0], v0[1]); w.y = cvt_pk_bf16(v0[2], v0[3]); w.z = cvt_pk_bf16(v1[0], v1[1]); w.w = cvt_pk_bf16(v1[2], v1[3]);
                    *(u32x4*)(rowp + bj * HALF) = w; } }
    }
};
struct EpiSwiglu {
    static constexpr bool PERM = true, AFTER_DRAIN = false;
    bf16_t* O; int ldc;
    __device__ __forceinline__ void operator()(const f32x4 (&acc)[2][2][4][2], const Unit& u, int wr, int wc, int fr, int fq) const {
        const int row0 = u.pm * BM + wr * 64 + fr, col0 = u.pn * HALF + wc * 32 + 8 * fq;
#pragma unroll
        for (int ai = 0; ai < 2; ++ai)
#pragma unroll
            for (int m = 0; m < 4; ++m) { bf16_t* rowp = O + (size_t)(row0 + ai * HALF + m * 16) * ldc + col0;
                float g[8];
#pragma unroll
                for (int n = 0; n < 2; ++n)
#pragma unroll
                    for (int e = 0; e < 4; ++e) { const float a = acc[ai][0][m][n][e], b = acc[ai][1][m][n][e]; g[n * 4 + e] = a * __builtin_amdgcn_rcpf(1.0f + __expf(-a)) * b; }
                u32x4 w; w.x = cvt_pk_bf16(g[0], g[1]); w.y = cvt_pk_bf16(g[2], g[3]); w.z = cvt_pk_bf16(g[4], g[5]); w.w = cvt_pk_bf16(g[6], g[7]);
                *(u32x4*)rowp = w; }
    }
};
struct EpiResGate {
    static constexpr bool PERM = false, AFTER_DRAIN = false;
    const float* base0; const float* base1; float* out; const float* gate;
    __device__ __forceinline__ void operator()(const f32x4 (&acc)[2][2][4][2], const Unit& u, int wr, int wc, int fr, int fq) const {
        const int rt = u.pm * BM; const bool lat = rt >= 8192;
        const float* bs = lat ? base1 - (size_t)8192 * 1024 : base0;
        const float* gt = gate + (lat ? 1 + ((rt - 8192) >> 11) : 0) * 6144;
        const int col0 = u.pn * BM + wc * 32 + 4 * fq;
#pragma unroll
        for (int bj = 0; bj < 2; ++bj)
#pragma unroll
            for (int n = 0; n < 2; ++n) { const int col = col0 + bj * HALF + n * 16; const f32x4 gv = *(const f32x4*)(gt + col);
#pragma unroll
                for (int ai = 0; ai < 2; ++ai)
#pragma unroll
                    for (int m = 0; m < 4; ++m) { const size_t off = (size_t)(rt + ai * HALF + wr * 64 + m * 16 + fr) * 1024 + col;
                        const f32x4 b = *(const f32x4*)(bs + off); *(f32x4*)(out + off) = b + gv * acc[ai][bj][m][n]; } }
    }
};
template <class Epi, class Sched, bool ALIGN_EPI = false, bool SP2 = false>
__device__ __forceinline__ void gemm_phase(PG8_LAS unsigned char* lds, const Gemm g, const Sched& S, const Epi& E) {
    const int tid = threadIdx.x, wid = __builtin_amdgcn_readfirstlane(tid >> 6), lane = tid & 63, wr = wid >> 2, wc = wid & 3, fr = lane & 15, fq = lane >> 4;
    const int K = g.K, nt = K / BK;
    unsigned voffA[2], voffB[2];
#pragma unroll
    for (int i = 0; i < 2; ++i) { int R, C; stage_rc(tid * 16 + i * 8192, R, C); const int Rb = Epi::PERM ? ((R & ~31) + perm32(R & 31)) : R;
        voffA[i] = (unsigned)(R * K + C) * 2u; voffB[i] = (unsigned)(Rb * K + C) * 2u; }
    const size_t kstep = (size_t)(BK * 2);
    const size_t hstep = (size_t)HALF * K * 2;
    const size_t tstep = 2 * hstep;
    const unsigned ldsw = (unsigned)wid * 1024u;
    const int aoff = lds_byte(wr * 64 + fr, fq * 8), boff = lds_byte(wc * 32 + fr, fq * 8);
#define PG8_SA(b, h) (((b) * 2 + (h)) * HTB)
#define PG8_SB(b, h) ((4 + (b) * 2 + (h)) * HTB)
#define PG8_STAGE(bufoff, gbase, voff) do { _Pragma("unroll") for (int _i = 0; _i < 2; ++_i) \
        __builtin_amdgcn_global_load_lds((const unsigned*)((const char*)(gbase) + (voff)[_i]), (PG8_LAS unsigned*)(lds + (bufoff) + ldsw + _i * 8192), 16, 0, 0); } while (0)
#define PG8_LDA(dst, b, h) do { _Pragma("unroll") for (int m = 0; m < 4; ++m) _Pragma("unroll") for (int k = 0; k < 2; ++k) dst[m][k] = *(const PG8_LAS bf16x8*)(lds + PG8_SA(b, h) + aoff + m * 2048 + k * 1024); } while (0)
#define PG8_LDB(dst, b, h) do { _Pragma("unroll") for (int n = 0; n < 2; ++n) _Pragma("unroll") for (int k = 0; k < 2; ++k) dst[n][k] = *(const PG8_LAS bf16x8*)(lds + PG8_SB(b, h) + boff + n * 2048 + k * 1024); } while (0)
#define PG8_MMA(ai, bj, At, Bt) do { __builtin_amdgcn_s_setprio(1); _Pragma("unroll") for (int m = 0; m < 4; ++m) _Pragma("unroll") for (int n = 0; n < 2; ++n) _Pragma("unroll") for (int k = 0; k < 2; ++k) \
        acc[ai][bj][m][n] = __builtin_amdgcn_mfma_f32_16x16x32_bf16(Bt[n][k], At[m][k], acc[ai][bj][m][n], 0, 0, 0); __builtin_amdgcn_s_setprio(0); } while (0)
#define PG8_WAIT_V(n) asm volatile("s_waitcnt vmcnt(" #n ")" ::: "memory")
#define PG8_WAIT_L(n) asm volatile("s_waitcnt lgkmcnt(" #n ")" ::: "memory")
#define PG8_BAR __builtin_amdgcn_s_barrier()
#define PG8_SCHED __builtin_amdgcn_sched_barrier(0)
    Unit cur, nxt; int ui = 0;
    if (!S.next(0, cur)) return;
    f32x4 acc[2][2][4][2];
#pragma unroll
    for (int a = 0; a < 2; ++a)
#pragma unroll
        for (int b = 0; b < 2; ++b)
#pragma unroll
            for (int m = 0; m < 4; ++m)
#pragma unroll
                for (int n = 0; n < 2; ++n) acc[a][b][m][n] = (f32x4){0.f, 0.f, 0.f, 0.f};
    bf16x8 At[4][2], B0[2][2], B1[2][2];
    const char* cA = (const char*)g.A + (size_t)cur.pm * tstep; const char* cB = (const char*)g.Bt + (size_t)cur.pn * tstep;
    S.a_ready(cur);
    if constexpr (SP2) {
        PG8_STAGE(PG8_SB(0, 0), cB, voffB); PG8_STAGE(PG8_SB(0, 1), cB + hstep, voffB); PG8_STAGE(PG8_SA(0, 0), cA, voffA); PG8_STAGE(PG8_SA(0, 1), cA + hstep, voffA);
        if (wr == 1) PG8_BAR;
        PG8_WAIT_V(2); PG8_BAR;
        PG8_STAGE(PG8_SB(1, 0), cB + kstep, voffB); PG8_STAGE(PG8_SA(1, 0), cA + kstep, voffA); PG8_STAGE(PG8_SB(1, 1), cB + hstep + kstep, voffB);
        PG8_WAIT_V(6); PG8_BAR;
    } else {
        PG8_STAGE(PG8_SB(0, 0), cB, voffB); PG8_STAGE(PG8_SA(0, 0), cA, voffA); PG8_STAGE(PG8_SB(0, 1), cB + hstep, voffB); PG8_STAGE(PG8_SA(0, 1), cA + hstep, voffA);
        if (wr == 1) PG8_BAR;
        PG8_WAIT_V(4); PG8_BAR;
        PG8_STAGE(PG8_SB(1, 0), cB + kstep, voffB); PG8_STAGE(PG8_SA(1, 0), cA + kstep, voffA); PG8_STAGE(PG8_SB(1, 1), cB + hstep + kstep, voffB);
        PG8_WAIT_V(6); PG8_BAR;
    }
    for (;;) {
        const bool has_next = S.next(ui + 1, nxt);
        const char* nA = has_next ? (const char*)g.A + (size_t)nxt.pm * tstep : cA; const char* nB = has_next ? (const char*)g.Bt + (size_t)nxt.pn * tstep : cB;
        for (int t = 0; t < nt; t += 2) {
            const bool last = (t == nt - 2);
            const char* a1 = cA + (size_t)(t + 1) * kstep;
            const char* a2 = last ? nA : cA + (size_t)(t + 2) * kstep; const char* b2 = last ? nB : cB + (size_t)(t + 2) * kstep;
            const char* a3 = a2 + kstep; const char* b3 = b2 + kstep;
            if (last && has_next) S.a_ready(nxt);
            if constexpr (SP2) {
            PG8_LDB(B0, 0, 0); PG8_LDB(B1, 0, 1); PG8_SCHED; PG8_LDA(At, 0, 0); PG8_STAGE(PG8_SA(1, 1), a1 + hstep, voffA);
            PG8_WAIT_V(8); PG8_WAIT_L(0); PG8_BAR; PG8_MMA(0, 0, At, B0); PG8_MMA(0, 1, At, B1); PG8_BAR; PG8_SCHED;
            PG8_LDA(At, 0, 1); PG8_STAGE(PG8_SB(0, 0), b2, voffB); PG8_STAGE(PG8_SB(0, 1), b2 + hstep, voffB); PG8_STAGE(PG8_SA(0, 0), a2, voffA);
            PG8_WAIT_V(8); PG8_WAIT_L(0); PG8_BAR; PG8_MMA(1, 0, At, B0); PG8_MMA(1, 1, At, B1); PG8_BAR; PG8_SCHED;
            PG8_LDB(B0, 1, 0); PG8_LDB(B1, 1, 1); PG8_SCHED; PG8_LDA(At, 1, 0); PG8_STAGE(PG8_SA(0, 1), a2 + hstep, voffA);
            PG8_WAIT_V(8); PG8_WAIT_L(0); PG8_BAR; PG8_MMA(0, 0, At, B0); PG8_MMA(0, 1, At, B1); PG8_BAR; PG8_SCHED;
            PG8_LDA(At, 1, 1); PG8_STAGE(PG8_SB(1, 0), b3, voffB); PG8_STAGE(PG8_SB(1, 1), b3 + hstep, voffB); PG8_STAGE(PG8_SA(1, 0), a3, voffA);
            PG8_WAIT_V(8); PG8_WAIT_L(0); PG8_BAR; PG8_MMA(1, 0, At, B0); PG8_MMA(1, 1, At, B1); PG8_BAR; PG8_SCHED;
            } else {
            PG8_LDB(B0, 0, 0); PG8_SCHED; PG8_LDA(At, 0, 0); PG8_STAGE(PG8_SA(1, 1), a1 + hstep, voffA);
            PG8_WAIT_L(8); PG8_BAR; PG8_WAIT_L(0); PG8_MMA(0, 0, At, B0); PG8_BAR; PG8_SCHED;
            PG8_LDB(B1, 0, 1); PG8_STAGE(PG8_SB(0, 0), b2, voffB);
            PG8_BAR; PG8_WAIT_L(0); PG8_MMA(0, 1, At, B1); PG8_BAR;
            PG8_LDA(At, 0, 1); PG8_STAGE(PG8_SA(0, 0), a2, voffA);
            PG8_BAR; PG8_WAIT_L(0); PG8_MMA(1, 0, At, B0); PG8_BAR; PG8_SCHED;
            PG8_STAGE(PG8_SB(0, 1), b2 + hstep, voffB);
            PG8_WAIT_V(6); PG8_BAR; PG8_MMA(1, 1, At, B1); PG8_BAR;
            PG8_LDB(B0, 1, 0); PG8_SCHED; PG8_LDA(At, 1, 0); PG8_STAGE(PG8_SA(0, 1), a2 + hstep, voffA);
            PG8_WAIT_L(8); PG8_BAR; PG8_WAIT_L(0); PG8_MMA(0, 0, At, B0); PG8_BAR; PG8_SCHED;
            PG8_LDB(B1, 1, 1); PG8_STAGE(PG8_SB(1, 0), b3, voffB);
            PG8_BAR; PG8_WAIT_L(0); PG8_MMA(0, 1, At, B1); PG8_BAR;
            PG8_LDA(At, 1, 1); PG8_STAGE(PG8_SA(1, 0), a3, voffA);
            PG8_BAR; PG8_WAIT_L(0); PG8_MMA(1, 0, At, B0); PG8_BAR; PG8_SCHED;
            PG8_STAGE(PG8_SB(1, 1), b3 + hstep, voffB);
            PG8_WAIT_V(6); PG8_BAR; PG8_MMA(1, 1, At, B1); PG8_BAR;
            }
        }
        if constexpr (ALIGN_EPI) { if (wr == 0) PG8_BAR; }
        if constexpr (!Epi::AFTER_DRAIN) { E(acc, cur, wr, wc, fr, fq); S.done(cur); }
        if (!has_next) break;
#pragma unroll
        for (int a = 0; a < 2; ++a)
#pragma unroll
            for (int b = 0; b < 2; ++b)
#pragma unroll
                for (int m = 0; m < 4; ++m)
#pragma unroll
                    for (int n = 0; n < 2; ++n) acc[a][b][m][n] = (f32x4){0.f, 0.f, 0.f, 0.f};
        cur = nxt; cA = nA; cB = nB; ++ui;
        if constexpr (ALIGN_EPI) { if (wr == 1) PG8_BAR; }
    }
    PG8_WAIT_V(0);
    if constexpr (!ALIGN_EPI) { if (wr == 0) PG8_BAR; }
    PG8_BAR;
    if constexpr (Epi::AFTER_DRAIN) { E.fused(acc, cur, wr, wc, fr, fq, lds, wid, lane); S.done(cur); }
#undef PG8_SA
#undef PG8_SB
#undef PG8_STAGE
#undef PG8_LDA
#undef PG8_LDB
#undef PG8_MMA
#undef PG8_WAIT_V
#undef PG8_WAIT_L
#undef PG8_BAR
#undef PG8_SCHED
}
}
#include <hip/hip_bf16.h>
#include <cmath>
namespace attn_body {
using bf16=__hip_bfloat16;
using bf16x8=__attribute__((ext_vector_type(8)))short;
using s16x4=__attribute__((ext_vector_type(4)))short;
using f32x16=__attribute__((ext_vector_type(16)))float;
using u32x4=__attribute__((ext_vector_type(4)))unsigned;
constexpr int D=64,QP=512,KP=128,OP=1024;
constexpr int NW=8,QBLK=32,QB=QBLK*NW,KVBLK=64;
constexpr int ATTN_UNIT_ROWS=QB;
__device__ __forceinline__ int crow(int r,int hi){return (r&3)+8*(r>>2)+4*hi;}
#define SBAR() __builtin_amdgcn_sched_barrier(0)
__device__ __forceinline__ void cmask(f32x16&p0,f32x16&p1,int jb,int qrel,int hi){
  const float NEG=-INFINITY; int kb=64*jb+4*hi;
  #pragma unroll
  for(int r=0;r<16;++r){int kv=kb+(r&3)+8*(r>>2); if(kv>qrel)p0[r]=NEG; if(kv+32>qrel)p1[r]=NEG;}
}

constexpr int NSLOT=3, SLOTB=8192;
constexpr int LDS_K=0, LDS_V=NSLOT*SLOTB, LDS_WS=2*NSLOT*SLOTB, LDS_OST=LDS_WS+NW*64*4, LDS_BYTES=LDS_OST+NW*4096;
constexpr float C2=0.125f*1.4426950408889634f;
__device__ __forceinline__ void glds16(const void*gsrc,unsigned lds_dst){unsigned keep;
  asm volatile("s_mov_b32 %0, m0\n\ts_mov_b32 m0, %2\n\ts_nop 0\n\tglobal_load_lds_dwordx4 %1, off\n\ts_mov_b32 m0, %0":"=&s"(keep):"v"(gsrc),"s"(lds_dst):"memory");}
__device__ __forceinline__ float max3f(float a,float b,float c){float r;asm("v_max3_f32 %0, %1, %2, %3":"=v"(r):"v"(a),"v"(b),"v"(c));return r;}
__device__ __forceinline__ float max2f(float a,float b){float r;asm("v_max_f32_e32 %0, %1, %2":"=v"(r):"v"(a),"v"(b));return r;}
__device__ __forceinline__ float fadd_s(float a,float b){float r;asm("v_add_f32_e32 %0, %1, %2":"=v"(r):"v"(a),"v"(b));return r;}
__device__ __forceinline__ float fsub_s(float a,float b){float r;asm("v_sub_f32_e32 %0, %1, %2":"=v"(r):"v"(a),"v"(b));return r;}
typedef float f32x2_t __attribute__((ext_vector_type(2))); typedef __bf16 bf16x2_t __attribute__((ext_vector_type(2)));
__device__ __forceinline__ unsigned cvtpk_s(float lo,float hi){f32x2_t v={lo,hi};bf16x2_t b=__builtin_convertvector(v,bf16x2_t);return __builtin_bit_cast(unsigned,b);}
#define WAIT_BAR(N) asm volatile("s_waitcnt vmcnt(" #N ") lgkmcnt(0)\n\ts_barrier":::"memory")

__device__ __forceinline__ void qkt(f32x16&p0,f32x16&p1,const char*Kslot,const bf16x8*qr,const f32x16&negm,int r32,int hi){
  const char*kb=Kslot+hi*1024+r32*16;
  #pragma unroll
  for(int d0=0;d0<4;++d0){
    const bf16x8 b0=*reinterpret_cast<const bf16x8*>(kb+d0*2048);
    const bf16x8 b1=*reinterpret_cast<const bf16x8*>(kb+d0*2048+512);
    if(d0==0){p0=__builtin_amdgcn_mfma_f32_32x32x16_bf16(b0,qr[0],negm,0,0,0);p1=__builtin_amdgcn_mfma_f32_32x32x16_bf16(b1,qr[0],negm,0,0,0);}
    else{p0=__builtin_amdgcn_mfma_f32_32x32x16_bf16(b0,qr[d0],p0,0,0,0);p1=__builtin_amdgcn_mfma_f32_32x32x16_bf16(b1,qr[d0],p1,0,0,0);}}
}
typedef __attribute__((address_space(3))) const char* lds_cptr;
typedef short v4i16_t __attribute__((ext_vector_type(4)));
__device__ __forceinline__ void kload8(bf16x8*kf,lds_cptr kp){
  kf[0]=*(const __attribute__((address_space(3))) bf16x8*)(kp);      kf[1]=*(const __attribute__((address_space(3))) bf16x8*)(kp+512);
  kf[2]=*(const __attribute__((address_space(3))) bf16x8*)(kp+2048); kf[3]=*(const __attribute__((address_space(3))) bf16x8*)(kp+2560);
  kf[4]=*(const __attribute__((address_space(3))) bf16x8*)(kp+4096); kf[5]=*(const __attribute__((address_space(3))) bf16x8*)(kp+4608);
  kf[6]=*(const __attribute__((address_space(3))) bf16x8*)(kp+6144); kf[7]=*(const __attribute__((address_space(3))) bf16x8*)(kp+6656);
}
__device__ __forceinline__ void kload2(bf16x8*kf,lds_cptr kp,int j){ kf[2*j]=*(const __attribute__((address_space(3))) bf16x8*)(kp+j*2048); kf[2*j+1]=*(const __attribute__((address_space(3))) bf16x8*)(kp+j*2048+512); }
__device__ __forceinline__ s16x4 vtr(lds_cptr p){ return __builtin_bit_cast(s16x4,__builtin_amdgcn_ds_read_tr16_b64_v4i16((__attribute__((address_space(3))) v4i16_t*)p)); }
__device__ __forceinline__ float rowmax(const f32x16&p0,const f32x16&p1){
  float a=max3f(p0[0],p0[1],p1[0]),b=max3f(p0[2],p0[3],p1[1]);a=max3f(a,p1[2],p1[3]);
  #pragma unroll
  for(int r=4;r<16;r+=4){a=max3f(a,p0[r],p0[r+1]);b=max3f(b,p0[r+2],p0[r+3]);a=max3f(a,p1[r],p1[r+1]);b=max3f(b,p1[r+2],p1[r+3]);}
  const float m=max2f(a,b);
  auto rr=__builtin_amdgcn_permlane32_swap(__float_as_uint(m),__float_as_uint(m),false,false);
  return max2f(__uint_as_float(rr[0]),__uint_as_float(rr[1]));
}
__device__ __forceinline__ void pv(f32x16*o,int vb,bf16x8 pa0,bf16x8 pa1,bf16x8 pa2,bf16x8 pa3){
  #pragma unroll
  for(int d0=0;d0<2;++d0){s16x4 lo[4],hi[4];
    #pragma unroll
    for(int ks=0;ks<4;++ks){
      asm volatile("ds_read_b64_tr_b16 %0,%1 offset:%c2":"=&v"(lo[ks]):"v"(vb),"i"(d0*4096+ks*1024):"memory");
      asm volatile("ds_read_b64_tr_b16 %0,%1 offset:%c2":"=&v"(hi[ks]):"v"(vb),"i"(d0*4096+ks*1024+512):"memory");}
    asm volatile("s_waitcnt lgkmcnt(0)":::"memory");SBAR();
    #define PK(k) (bf16x8){lo[k][0],lo[k][1],lo[k][2],lo[k][3],hi[k][0],hi[k][1],hi[k][2],hi[k][3]}
    o[d0]=__builtin_amdgcn_mfma_f32_32x32x16_bf16(pa0,PK(0),o[d0],0,0,0);
    o[d0]=__builtin_amdgcn_mfma_f32_32x32x16_bf16(pa1,PK(1),o[d0],0,0,0);
    o[d0]=__builtin_amdgcn_mfma_f32_32x32x16_bf16(pa2,PK(2),o[d0],0,0,0);
    o[d0]=__builtin_amdgcn_mfma_f32_32x32x16_bf16(pa3,PK(3),o[d0],0,0,0);
    #undef PK
  }
}

#ifndef ATTN_STORE16
#define ATTN_STORE16(p,v) (*(u32x4*)(p)=(v))
#endif
template<int THRL> __device__ __forceinline__ void attn_unit(long qrow0,int h,long kvrow0,int NT,const bf16*Q,const bf16*__restrict__ K,const bf16*__restrict__ V,bf16*O,char*shm){
  const int tid=threadIdx.x,lane=tid&63,r32=lane&31,hi=lane>>5; const int wid=__builtin_amdgcn_readfirstlane(tid>>6);
  const bf16*Qw=Q+(qrow0+wid*QBLK)*QP+h*D;
  const bf16*Kh=K+kvrow0*KP+(h>>2)*D,*Vh=V+kvrow0*KP+(h>>2)*D;
  const unsigned lds0=(unsigned)(uintptr_t)shm;
  float*wsf=(float*)(shm+LDS_WS)+wid*64;
  const bf16*ksrc=Kh+(long)lane*KP+wid*8;
  const bf16*vsrc=Vh+(long)(16*(wid&3)+(lane>>2))*KP+(wid>>2)*32+(lane&3)*8;
  const unsigned kdst=lds0+LDS_K+wid*1024, vdst=lds0+LDS_V+wid*1024;
  #define DMA_K(t,slot) glds16(ksrc+(long)(t)*KVBLK*KP,(unsigned)__builtin_amdgcn_readfirstlane(kdst+(slot)))
  #define DMA_V(t,slot) glds16(vsrc+(long)(t)*KVBLK*KP,(unsigned)__builtin_amdgcn_readfirstlane(vdst+(slot)))
  const int vb0=(int)(lds0+LDS_V)+((lane>>4)&1)*32+(lane&3)*8+(4*hi+((lane&15)>>2))*64;
  const char*Kbase=shm+LDS_K; bf16x8 kf[8];
  const lds_cptr shm3=(lds_cptr)shm; const lds_cptr kp0=shm3+LDS_K+hi*1024+r32*16; const lds_cptr vp0=shm3+LDS_V+((lane>>4)&1)*32+(lane&3)*8+(4*hi+((lane&15)>>2))*64;
  DMA_K(0,0);DMA_V(0,0);DMA_K(1,SLOTB);
  bf16x8 qr[4];
  #pragma unroll
  for(int d0=0;d0<4;++d0)qr[d0]=*reinterpret_cast<const bf16x8*>(&Qw[(long)r32*QP+d0*16+hi*8]);
  float mhat=0.f,l_reg=0.f;f32x16 o[2];o[0]=f32x16{};o[1]=f32x16{};f32x16 negm=f32x16{};asm volatile("":"+v"(negm));
  (void)0;
  #define CMASK(P0,P1,t) do{}while(0)
  bool resc=false;
  #define START(P0,P1) do{ const float rm=rowmax(P0,P1); resc=false; \
    { const float dl=rm; mhat=fadd_s(mhat,dl); \
      _Pragma("unroll") for(int r=0;r<16;++r){P0[r]=fsub_s(P0[r],dl);P1[r]=fsub_s(P1[r],dl);} \
      _Pragma("unroll") for(int r=0;r<16;++r)negm[r]=-mhat; asm volatile("":"+v"(negm)); } \
    _Pragma("unroll") for(int r=0;r<16;++r)P0[r]=__builtin_amdgcn_exp2f(P0[r]); }while(0)
  #define RESC() do{ if(resc){ asm volatile("s_waitcnt lgkmcnt(0)":::"memory"); \
      _Pragma("unroll") for(int d_=0;d_<2;++d_) _Pragma("unroll") for(int r=0;r<16;++r)o[d_][r]*=wsf[crow(r,hi)]; } }while(0)
  f32x16 pA0,pA1,pB0,pB1;
  int sl_prev=0,sl_cur=0,sl_next=SLOTB;
  #define ROT() do{sl_prev=sl_cur;sl_cur=sl_next;sl_next=(sl_next==(NSLOT-1)*SLOTB)?0:sl_next+SLOTB;}while(0)
  DMA_K(2,2*SLOTB);
  WAIT_BAR(3);
  qkt(pA0,pA1,Kbase,qr,negm,r32,hi);asm volatile("s_nop 15\n\ts_nop 7":"+v"(pA0),"+v"(pA1));CMASK(pA0,pA1,0);
  START(pA0,pA1);
  _Pragma("unroll") for(int r=0;r<16;++r)pA1[r]=__builtin_amdgcn_exp2f(pA1[r]);
  WAIT_BAR(0);
  DMA_K(3,0);DMA_V(1,SLOTB);
  ROT();
  kload8(kf,kp0+sl_cur);
  WAIT_BAR(2);
  s16x4 vlo[8],vhi[8]; u32x4 pw0,pw1,pw2,pw3;
  #define PKW(P,B) cvtpk_s(P[B],P[B+1])
  #define PAF(k) __builtin_bit_cast(bf16x8,pw##k)
  #define VFR(i) (bf16x8){vlo[i][0],vlo[i][1],vlo[i][2],vlo[i][3],vhi[i][0],vhi[i][1],vhi[i][2],vhi[i][3]}
  #define PIN(x) asm volatile("":"+v"(x))
  #define MX3(a,b,c) __builtin_fmaxf(__builtin_fmaxf((a),(b)),(c))
  #define GAPA(MF,A0,A1,A2,A3,W0,W1,PW) do{ MF; sacc+=A0; sacc+=A1; sacc+=A2; sacc+=A3; PIN(sacc); W0; W1; PIN(PW); SBAR(); }while(0)
  #define EX(v) __builtin_amdgcn_exp2f(v)
  #define GAPB(MF,X,B) do{ MF; X[B]=EX(X[B]); X[B+1]=EX(X[B+1]); X[B+2]=EX(X[B+2]); X[B+3]=EX(X[B+3]); PIN(X); SBAR(); }while(0)
  #define VRD(i) do{ vlo[i]=vtr(vp_+(((i)>>2)*4096+((i)&3)*1024)); vhi[i]=vtr(vp_+(((i)>>2)*4096+((i)&3)*1024+512)); }while(0)
  #define KRD(G,j) do{ if(G){ kload2(kf,kp0+sl_next,j); SBAR(); } }while(0)
  #define STEP(C0,C1,P0,P1,t,GK,GV,GL) do{ SBAR(); \
    const lds_cptr vp_=vp0+sl_prev; \
    VRD(0); SBAR(); float sacc=(P0[0]+P0[1]); \
    GAPA(C0=__builtin_amdgcn_mfma_f32_32x32x16_bf16(kf[0],qr[0],negm,0,0,0), P0[2],P0[3],P0[4],P0[5],     pw0[0]=PKW(P0,0), pw0[1]=PKW(P0,2), pw0); \
    VRD(4); SBAR(); GAPA(C1=__builtin_amdgcn_mfma_f32_32x32x16_bf16(kf[1],qr[0],negm,0,0,0), P0[6],P0[7],P0[8],P0[9],     pw0[2]=PKW(P0,4), pw0[3]=PKW(P0,6), pw0); \
    VRD(1); SBAR(); GAPA(C0=__builtin_amdgcn_mfma_f32_32x32x16_bf16(kf[2],qr[1],C0,0,0,0),   P0[10],P0[11],P0[12],P0[13], pw1[0]=PKW(P0,8), pw1[1]=PKW(P0,10), pw1); \
    VRD(5); SBAR(); GAPA(C1=__builtin_amdgcn_mfma_f32_32x32x16_bf16(kf[3],qr[1],C1,0,0,0),   P0[14],P0[15],P1[0],P1[1],   pw1[2]=PKW(P0,12),pw1[3]=PKW(P0,14), pw1); \
    VRD(2); SBAR(); GAPA(C0=__builtin_amdgcn_mfma_f32_32x32x16_bf16(kf[4],qr[2],C0,0,0,0),   P1[2],P1[3],P1[4],P1[5],     pw2[0]=PKW(P1,0), pw2[1]=PKW(P1,2), pw2); \
    VRD(6); SBAR(); GAPA(C1=__builtin_amdgcn_mfma_f32_32x32x16_bf16(kf[5],qr[2],C1,0,0,0),   P1[6],P1[7],P1[8],P1[9],     pw2[2]=PKW(P1,4), pw2[3]=PKW(P1,6), pw2); \
    VRD(3); SBAR(); GAPA(C0=__builtin_amdgcn_mfma_f32_32x32x16_bf16(kf[6],qr[3],C0,0,0,0),   P1[10],P1[11],P1[12],P1[13], pw3[0]=PKW(P1,8), pw3[1]=PKW(P1,10), pw3); \
    VRD(7); SBAR(); GAPA(C1=__builtin_amdgcn_mfma_f32_32x32x16_bf16(kf[7],qr[3],C1,0,0,0),   P1[14],P1[15],0.f,0.f,       pw3[2]=PKW(P1,12),pw3[3]=PKW(P1,14), pw3); \
    l_reg+=sacc; \
    if(GK){DMA_K((t)+3,sl_cur);} if(GV){DMA_V((t)+1,sl_next);} \
    CMASK(C0,C1,t); \
    { float a=MX3(C0[0],C0[1],C1[0]),b=MX3(C0[2],C0[3],C1[1]); a=MX3(a,C1[2],C1[3]); \
      _Pragma("unroll") for(int r=4;r<16;r+=4){a=MX3(a,C0[r],C0[r+1]);b=MX3(b,C0[r+2],C0[r+3]);a=MX3(a,C1[r],C1[r+1]);b=MX3(b,C1[r+2],C1[r+3]);} \
      float rm=__builtin_fmaxf(a,b); { auto rr=__builtin_amdgcn_permlane32_swap(__float_as_uint(rm),__float_as_uint(rm),false,false); rm=__builtin_fmaxf(__uint_as_float(rr[0]),__uint_as_float(rr[1])); } \
      resc=false; \
      if(__builtin_expect(__any(rm>(float)THRL),0)){ const float dl=__builtin_fmaxf(rm,0.f); mhat+=dl; \
        _Pragma("unroll") for(int r=0;r<16;++r){C0[r]-=dl;C1[r]-=dl;} \
        _Pragma("unroll") for(int r=0;r<16;++r)negm[r]=-mhat; asm volatile("":"+v"(negm)); \
        const float f=__builtin_amdgcn_exp2f(-dl); l_reg*=f; if(hi==0)wsf[r32]=f; resc=true; } } \
    SBAR(); \
    GAPB(o[0]=__builtin_amdgcn_mfma_f32_32x32x16_bf16(PAF(0),VFR(0),o[0],0,0,0), C0,0); \
    GAPB(o[1]=__builtin_amdgcn_mfma_f32_32x32x16_bf16(PAF(0),VFR(4),o[1],0,0,0), C0,4); \
    KRD(GL,0); GAPB(o[0]=__builtin_amdgcn_mfma_f32_32x32x16_bf16(PAF(1),VFR(1),o[0],0,0,0), C0,8); \
    KRD(GL,1); GAPB(o[1]=__builtin_amdgcn_mfma_f32_32x32x16_bf16(PAF(1),VFR(5),o[1],0,0,0), C0,12); \
    KRD(GL,2); GAPB(o[0]=__builtin_amdgcn_mfma_f32_32x32x16_bf16(PAF(2),VFR(2),o[0],0,0,0), C1,0); \
    KRD(GL,3); GAPB(o[1]=__builtin_amdgcn_mfma_f32_32x32x16_bf16(PAF(2),VFR(6),o[1],0,0,0), C1,4); \
    GAPB(o[0]=__builtin_amdgcn_mfma_f32_32x32x16_bf16(PAF(3),VFR(3),o[0],0,0,0), C1,8); \
    GAPB(o[1]=__builtin_amdgcn_mfma_f32_32x32x16_bf16(PAF(3),VFR(7),o[1],0,0,0), C1,12); \
    }while(0)
  int t=1;
  #undef CMASK
  #define CMASK(P0,P1,t) do{}while(0)
  for(;t+5<NT;t+=2){
    STEP(pB0,pB1,pA0,pA1,t,true,true,true);     WAIT_BAR(2); RESC(); ROT();
    STEP(pA0,pA1,pB0,pB1,t+1,true,true,true);   WAIT_BAR(2); RESC(); ROT();
  }
  #undef CMASK
  #define CMASK(P0,P1,t) do{}while(0)
  #define ENDW(tt) do{ if((tt)+3<NT){WAIT_BAR(2);} else if((tt)+2<NT){WAIT_BAR(1);} else {WAIT_BAR(0);} }while(0)
  for(;t+1<NT;t+=2){
    STEP(pB0,pB1,pA0,pA1,t,(t+3<NT),(t+1<NT),(t+1<NT));       ENDW(t);   RESC(); ROT();
    STEP(pA0,pA1,pB0,pB1,t+1,(t+4<NT),(t+2<NT),(t+2<NT));     ENDW(t+1); RESC(); ROT();
  }
  STEP(pB0,pB1,pA0,pA1,NT-1,false,false,false); RESC();
  { float sacc=pB0[0]+pB0[1]; _Pragma("unroll") for(int r=2;r<16;++r)sacc+=pB0[r]; _Pragma("unroll") for(int r=0;r<16;++r)sacc+=pB1[r]; l_reg+=sacc;
    pw0=(u32x4){PKW(pB0,0),PKW(pB0,2),PKW(pB0,4),PKW(pB0,6)};pw1=(u32x4){PKW(pB0,8),PKW(pB0,10),PKW(pB0,12),PKW(pB0,14)};pw2=(u32x4){PKW(pB1,0),PKW(pB1,2),PKW(pB1,4),PKW(pB1,6)};pw3=(u32x4){PKW(pB1,8),PKW(pB1,10),PKW(pB1,12),PKW(pB1,14)};
    SBAR(); pv(o,vb0+sl_cur,PAF(0),PAF(1),PAF(2),PAF(3)); }
  #undef PKW
  #undef PAF
  #undef VFR
  #undef PIN
  #undef MX3
  #undef GAPA
  #undef GAPB
  #undef EX
  #undef VRD
  #undef KRD
  #undef STEP
  #undef ENDW
  {auto rr=__builtin_amdgcn_permlane32_swap(__float_as_uint(l_reg),__float_as_uint(l_reg),false,false);l_reg=__uint_as_float(rr[0])+__uint_as_float(rr[1]);}
  if(hi==0)wsf[32+r32]=l_reg;asm volatile("s_waitcnt lgkmcnt(0)":::"memory");
  float rli[16];
  #pragma unroll
  for(int r=0;r<16;++r)rli[r]=__builtin_amdgcn_rcpf(wsf[32+crow(r,hi)]);
  bf16*Ow=O+(qrow0+wid*QBLK)*OP+h*D;
  { bf16*stg=(bf16*)(shm+LDS_OST)+wid*2048;
    #pragma unroll
    for(int r=0;r<16;++r){const int orow=crow(r,hi);
      #pragma unroll
      for(int d0=0;d0<2;++d0)stg[orow*64+d0*32+r32]=__float2bfloat16(o[d0][r]*rli[r]);}
    asm volatile("s_waitcnt lgkmcnt(0)":::"memory");
    #pragma unroll
    for(int i=0;i<4;++i){const int row=i*8+(lane>>3),ch=lane&7; const u32x4 v=*(const u32x4*)(stg+row*64+ch*8); ATTN_STORE16(Ow+(long)row*OP+ch*8,v);} }
  asm volatile("s_waitcnt lgkmcnt(0)\n\ts_barrier":::"memory");
  #undef DMA_K
  #undef DMA_V
  #undef CMASK
  #undef START
  #undef RESC
  #undef ROT
}
constexpr int ATTN_LDS_BYTES=LDS_BYTES;
#undef SBAR
#undef WAIT_BAR
}
constexpr int NWAVES = 8, NT_BLK = NWAVES * 64;
constexpr int DM = 1024, MROWS = 12288, MCTX = 8192, TLAT = 2048, TCTX = 256, PAST = 256;
constexpr int NPROJ = 2336, LDP = 2560;
constexpr int DFF = 2816;
constexpr int C_QG = 0, C_KG = 256, C_VG = 512, C_OG = 1024, C_LR = 1536, C_QA = 1568, C_KA = 2080, C_VA = 2208;
constexpr int KVLAT = TLAT + PAST;
constexpr int NCHUNK = MROWS / 64, NITEM = NCHUNK * 4;
constexpr float EPS = 1e-6f;
constexpr size_t MiB = 1u << 20;
constexpr size_t WS_MOD = 1 * MiB, WS_DECAY = 2 * MiB, WS_WIN = 3 * MiB, WS_WOUT = 8 * MiB, WS_W13 = 10 * MiB, WS_W2 = 21 * MiB;
constexpr size_t WS_KVK = 27 * MiB, WS_KVV = 31 * MiB, WS_XN = 35 * MiB, WS_MIX = 59 * MiB, WS_PROJ = 83 * MiB, WS_QB = 143 * MiB, WS_G = 83 * MiB;
constexpr size_t WS_U = 155 * MiB, WS_SPREV = 203 * MiB, WS_END = 227 * MiB;
static_assert(WS_PROJ + (size_t)MROWS * LDP * 2 <= WS_QB && WS_QB + (size_t)MROWS * 512 * 2 <= WS_U && WS_G + (size_t)MROWS * DFF * 2 <= WS_U, "ws map");
static_assert(WS_U + (size_t)NITEM * 2 * 8192 * 4 <= WS_SPREV && WS_SPREV + (size_t)NITEM * 2 * 8192 * 2 <= WS_END, "ws map 2");
constexpr int LDS_BYTES = 147456;
constexpr size_t OUT_K = (size_t)MROWS * DM, OUT_V = OUT_K + 1048576, OUT_SF = OUT_V + 1048576, OUT_SB = OUT_SF + 1048576;

#define LAS __attribute__((address_space(3)))
typedef unsigned short bf16;
typedef unsigned v4u __attribute__((ext_vector_type(4)));
typedef unsigned v2u __attribute__((ext_vector_type(2)));
typedef float f32x4 __attribute__((ext_vector_type(4)));
typedef short bf16x8 __attribute__((ext_vector_type(8)));
#define LDS_WAIT() asm volatile("s_waitcnt lgkmcnt(0)" ::: "memory")
__device__ __forceinline__ unsigned f2bf(float f) { unsigned u = __builtin_bit_cast(unsigned, f); return (u + 0x7fffu + ((u >> 16) & 1u)) >> 16; }
__device__ __forceinline__ unsigned pk2(float lo, float hi) { return f2bf(lo) | (f2bf(hi) << 16); }
__device__ __forceinline__ float bflo(unsigned u) { return __builtin_bit_cast(float, u << 16); }
__device__ __forceinline__ float bfhi(unsigned u) { return __builtin_bit_cast(float, u & 0xffff0000u); }
__device__ __forceinline__ float bf1(bf16 b) { return __builtin_bit_cast(float, (unsigned)b << 16); }
__device__ __forceinline__ float wave_sum(float v) {
#pragma unroll
    for (int o = 1; o < 64; o <<= 1) v += __shfl_xor(v, o);
    return v;
}
__device__ __forceinline__ float siluf(float x) { return x / (1.0f + __expf(-x)); }
__device__ __forceinline__ float logsigf(float x) { return fminf(x, 0.f) - log1pf(__expf(-fabsf(x))); }

struct Args { const float* in[23]; float* out; unsigned char* ws; int ph_lo, ph_hi; };

__device__ __forceinline__ void p0_transpose_item(const float* W, int K, int N, bf16* WT, int k0, int n0, int drow0, LAS float* scr, int lane) {
#pragma unroll 8
    for (int i = 0; i < 32; ++i) { const int kk = 2 * i + (lane >> 5); scr[kk * 33 + (lane & 31)] = W[(size_t)(k0 + kk) * N + n0 + (lane & 31)]; }
    LDS_WAIT(); asm volatile("" ::: "memory");
    const int c = lane & 7;
#pragma unroll
    for (int j = 0; j < 4; ++j) { const int n = (lane >> 3) + 8 * j; const LAS float* s = scr + (8 * c) * 33 + n;
        v4u o; o.x = pk2(s[0 * 33], s[1 * 33]); o.y = pk2(s[2 * 33], s[3 * 33]); o.z = pk2(s[4 * 33], s[5 * 33]); o.w = pk2(s[6 * 33], s[7 * 33]);
        *(v4u*)(WT + (size_t)(drow0 + n) * K + k0 + 8 * c) = o; }
    LDS_WAIT(); asm volatile("" ::: "memory");
}
__device__ __forceinline__ void p0_adaln(LAS unsigned char* lds, const float* c_lat, const float* c_ctx, const float* ada_w, const float* ada_b, float* MOD, int tid) {
    LAS float* ST = (LAS float*)lds; LAS float* RED = (LAS float*)(lds + 12288);
    for (int i = tid; i < 3072; i += NT_BLK) { const int cc = i >> 10, k = i & 1023; const float x = cc == 0 ? c_ctx[k] : c_lat[(cc - 1) * 1024 + k]; ST[i] = siluf(x); }
    __syncthreads();
    for (int cb = blockIdx.x; cb < 256; cb += gridDim.x) {
        const int n0 = cb * 24;
        if (tid < 384) {
            const int cg_ = tid % 6, ks = tid / 6;
            f32x4 a0 = {0.f, 0.f, 0.f, 0.f}, a1 = a0, a2 = a0;
#pragma unroll 16
            for (int kk = 0; kk < 16; ++kk) { const int k = ks * 16 + kk; const f32x4 w = *(const f32x4*)(ada_w + (size_t)k * 6144 + n0 + cg_ * 4);
                a0 += w * ST[k]; a1 += w * ST[1024 + k]; a2 += w * ST[2048 + k]; }
            LAS float* r = RED + (ks * 6 + cg_) * 12;
#pragma unroll
            for (int e = 0; e < 4; ++e) { r[e] = a0[e]; r[4 + e] = a1[e]; r[8 + e] = a2[e]; }
        }
        __syncthreads();
        if (tid < 72) { const int cc = tid / 24, col = tid % 24, cg_ = col >> 2, e = col & 3; float s = 0.f;
            for (int ks = 0; ks < 64; ++ks) s += RED[(ks * 6 + cg_) * 12 + cc * 4 + e];
            MOD[cc * 6144 + n0 + col] = s + ada_b[n0 + col]; }
        __syncthreads();
    }
}
__device__ __forceinline__ void norm_mod_row(const float* xrow, const float* gain, const float* shift, const float* scale, bf16* orow, int lane) {
    const f32x4* xr = (const f32x4*)xrow + lane; f32x4 v[4]; float s = 0.f;
#pragma unroll
    for (int j = 0; j < 4; ++j) { v[j] = xr[64 * j]; s += (v[j].x * v[j].x + v[j].y * v[j].y) + (v[j].z * v[j].z + v[j].w * v[j].w); }
    const float rstd = 1.0f / sqrtf(wave_sum(s) * (1.f / DM) + EPS);
    v2u* o8 = (v2u*)orow + lane;
#pragma unroll
    for (int j = 0; j < 4; ++j) { const f32x4 g = ((const f32x4*)gain)[lane + 64 * j], sh = ((const f32x4*)shift)[lane + 64 * j], sc = ((const f32x4*)scale)[lane + 64 * j];
        const f32x4 h = (v[j] * rstd * g) * (sc + 1.0f) + sh; v2u w; w.x = pk2(h.x, h.y); w.y = pk2(h.z, h.w); o8[64 * j] = w; }
}
__device__ __forceinline__ void final_norm_row(float* xrow, const float* gain, int lane) {
    f32x4* xr = (f32x4*)xrow + lane; f32x4 v[4]; float s = 0.f;
#pragma unroll
    for (int j = 0; j < 4; ++j) { v[j] = xr[64 * j]; s += (v[j].x * v[j].x + v[j].y * v[j].y) + (v[j].z * v[j].z + v[j].w * v[j].w); }
    const float rstd = 1.0f / sqrtf(wave_sum(s) * (1.f / DM) + EPS);
#pragma unroll
    for (int j = 0; j < 4; ++j) xr[64 * j] = v[j] * rstd * ((const f32x4*)gain)[lane + 64 * j];
}
__device__ __forceinline__ void prep_row(int r, const bf16* PROJ, const float* qg, const float* kg, bf16* QB, bf16* KVK, bf16* KVV, float* out, int lane) {
    const bool lat = r >= MCTX; const bf16* prow = PROJ + (size_t)r * LDP;
    float cs = 1.f, sn = 0.f; size_t kvrow = (size_t)r;
    if (lat) { const int rr = r - MCTX, b = rr >> 11, t = rr & 2047; kvrow = (size_t)MCTX + (size_t)b * KVLAT + t;
        const int a = lane >> 5, f = lane & 15; const float pos = (float)(a ? (t & 63) : (t >> 6));
        const float inv = exp2f(-(float)f * (13.287712379549449f / 16.0f));
        sincosf(pos * inv, &sn, &cs); }
    const bool p1 = (lane >> 4) & 1;
    const float gq = qg[lane], gk = kg[lane];
    constexpr float C2 = 0.125f * 1.4426950408889634f;
#pragma unroll
    for (int hh = 0; hh < 8; ++hh) { const float x = bf1(prow[C_QA + hh * 64 + lane]); const float ss = wave_sum(x * x);
        float y = x * (1.0f / sqrtf(ss * (1.f / 64.f) + EPS)) * gq;
        if (lat) { const float o = __shfl_xor(y, 16); y = p1 ? (o * sn + y * cs) : (y * cs - o * sn); }
        QB[(size_t)r * 512 + hh * 64 + lane] = (bf16)f2bf(y * C2); }
#pragma unroll
    for (int kh = 0; kh < 2; ++kh) { const float x = bf1(prow[C_KA + kh * 64 + lane]); const float ss = wave_sum(x * x);
        float y = x * (1.0f / sqrtf(ss * (1.f / 64.f) + EPS)) * gk;
        if (lat) { const float o = __shfl_xor(y, 16); y = p1 ? (o * sn + y * cs) : (y * cs - o * sn); }
        else out[OUT_K + (size_t)r * 128 + kh * 64 + lane] = y;
        KVK[kvrow * 128 + kh * 64 + lane] = (bf16)f2bf(y); }
    { const unsigned raw = *(const unsigned*)(prow + C_VA + 2 * lane);
      *(unsigned*)(KVV + kvrow * 128 + 2 * lane) = raw;
      if (!lat) { float2 o; o.x = bflo(raw); o.y = bfhi(raw); *(float2*)(out + OUT_V + (size_t)r * 128 + 2 * lane) = o; } }
}
constexpr int GL_LR = 0;
constexpr int GL_GB = 8192;
constexpr int GL_O = 0;
constexpr int GL_A = 41472;
constexpr int GL_BT = GL_A + 64 * 400;
constexpr int GL_KT = GL_BT + 128 * 400;
constexpr int GL_END = GL_KT + 2 * 64 * 144;
static_assert(GL_END <= LDS_BYTES - 1024 && 64 * 132 * 4 <= GL_A, "GLA LDS map");
constexpr int GA_S = 200, GK_S = 72;

__device__ __forceinline__ void gla_gates(LAS unsigned char* lds, const bf16* PROJ, const float* w_gk2, const float* b_gk2, int c, int h, int tid) {
    LAS float* LR = (LAS float*)(lds + GL_LR); LAS float* GB = (LAS float*)(lds + GL_GB);
    { const int i = tid >> 3, c4 = (tid & 7) * 4; const v2u raw = *(const v2u*)(PROJ + (size_t)(64 * c + i) * LDP + C_LR + c4);
      LR[i * 32 + c4] = bflo(raw.x); LR[i * 32 + c4 + 1] = bfhi(raw.x); LR[i * 32 + c4 + 2] = bflo(raw.y); LR[i * 32 + c4 + 3] = bfhi(raw.y); }
    __syncthreads();
    { const int d = tid & 63, ig = tid >> 6; float w0[16], w1[16];
#pragma unroll
      for (int l = 0; l < 16; ++l) { w0[l] = w_gk2[l * 256 + h * 64 + d]; w1[l] = w_gk2[(16 + l) * 256 + h * 64 + d]; }
      const float b0 = b_gk2[h * 64 + d], b1 = b_gk2[256 + h * 64 + d];
#pragma unroll
      for (int r = 0; r < 8; ++r) { const int i = ig * 8 + r; float a0 = b0, a1 = b1;
#pragma unroll
          for (int l = 0; l < 16; ++l) { a0 += LR[i * 32 + l] * w0[l]; a1 += LR[i * 32 + 16 + l] * w1[l]; }
          GB[i * 65 + d] = logsigf(a0) * (1.f / 16.f); GB[(64 + i) * 65 + d] = logsigf(a1) * (1.f / 16.f); } }
    __syncthreads();
    if (tid < 128) { const int d = tid & 63; float s = 0.f;
        if (tid < 64) { for (int i = 0; i < 64; ++i) { s += GB[i * 65 + d]; GB[i * 65 + d] = s; } }
        else { for (int i = 63; i >= 0; --i) { s += GB[(64 + i) * 65 + d]; GB[(64 + i) * 65 + d] = s; } } }
    __syncthreads();
}
__device__ __forceinline__ void gla_load_vt(LAS bf16* dst, int stride, const bf16* PROJ, int c, int h, int tid) {
    const int j = tid & 63, vg = tid >> 6;
#pragma unroll
    for (int p = 0; p < 2; ++p) { const int v0 = (vg + 8 * p) * 8; const v4u raw = *(const v4u*)(PROJ + (size_t)(64 * c + j) * LDP + C_VG + h * 128 + v0);
#pragma unroll
        for (int e = 0; e < 4; ++e) { dst[(v0 + 2 * e) * stride + j] = (bf16)(raw[e] & 0xffffu); dst[(v0 + 2 * e + 1) * stride + j] = (bf16)(raw[e] >> 16); } }
}
__device__ __forceinline__ void gla_u_item(LAS unsigned char* lds, const bf16* PROJ, const float* w_gk2, const float* b_gk2, float* U, float* DECAY, int item, int tid) {
    const int c = item >> 2, h = item & 3, lane = tid & 63, w = tid >> 6;
    LAS float* GB = (LAS float*)(lds + GL_GB); LAS bf16* VT = (LAS bf16*)(lds + GL_A); LAS bf16* KE = (LAS bf16*)(lds + GL_KT);
    gla_gates(lds, PROJ, w_gk2, b_gk2, c, h, tid);
    gla_load_vt(VT, GK_S, PROJ, c, h, tid);
    { const int j = tid & 63, dg = tid >> 6; const v4u raw = *(const v4u*)(PROJ + (size_t)(64 * c + j) * LDP + C_KG + h * 64 + dg * 8);
#pragma unroll
      for (int e = 0; e < 8; ++e) { const int d = dg * 8 + e; const float k = (e & 1) ? bfhi(raw[e >> 1]) : bflo(raw[e >> 1]);
          const float ef = __expf(GB[63 * 65 + d] - GB[j * 65 + d]), eb = __expf(GB[64 * 65 + d] - GB[(64 + j) * 65 + d]);
          KE[d * GK_S + j] = (bf16)f2bf(k * ef); KE[(64 + d) * GK_S + j] = (bf16)f2bf(k * eb); } }
    if (tid < 128) { const int d = tid & 63, dir = tid >> 6; DECAY[((size_t)item * 2 + dir) * 64 + d] = __expf(dir ? GB[64 * 65 + d] : GB[63 * 65 + d]); }
    __syncthreads();
    f32x4 acc[2][4];
#pragma unroll
    for (int dir = 0; dir < 2; ++dir)
#pragma unroll
        for (int nt = 0; nt < 4; ++nt) acc[dir][nt] = (f32x4){0.f, 0.f, 0.f, 0.f};
#pragma unroll
    for (int ks = 0; ks < 2; ++ks) { const bf16x8 a = *(const LAS bf16x8*)(VT + (16 * w + (lane & 15)) * GK_S + ks * 32 + (lane >> 4) * 8);
#pragma unroll
        for (int dir = 0; dir < 2; ++dir)
#pragma unroll
            for (int nt = 0; nt < 4; ++nt) { const bf16x8 b = *(const LAS bf16x8*)(KE + (dir * 64 + 16 * nt + (lane & 15)) * GK_S + ks * 32 + (lane >> 4) * 8);
                acc[dir][nt] = __builtin_amdgcn_mfma_f32_16x16x32_bf16(a, b, acc[dir][nt], 0, 0, 0); } }
#pragma unroll
    for (int dir = 0; dir < 2; ++dir) { float* up = U + ((size_t)item * 2 + dir) * 8192;
#pragma unroll
        for (int nt = 0; nt < 4; ++nt)
#pragma unroll
            for (int r = 0; r < 4; ++r) up[(16 * w + (lane >> 4) * 4 + r) * 64 + 16 * nt + (lane & 15)] = acc[dir][nt][r]; }
    __syncthreads();
}
__device__ __forceinline__ void gla_scan(const float* __restrict__ U, const float* __restrict__ DECAY, bf16* __restrict__ SPREV, const float* __restrict__ sf_in, const float* __restrict__ sb_in, float* __restrict__ out, int tid) {
    for (int job = blockIdx.x; job < 256 + 4096; job += gridDim.x) {
        const bool lat = job < 256; const int j2 = lat ? job : job - 256; const int chain = j2 >> 4, eb = j2 & 15;
        const int b = chain >> 3, h = (chain >> 1) & 3, dir = chain & 1; const int N = lat ? 32 : 4, cbase = lat ? 128 + b * 32 : b * 4;
        const int e = eb * 512 + tid, v = e >> 6, d = e & 63;
        float s = 0.f;
        if (lat) s = (dir ? sb_in : sf_in)[((size_t)(b * 4 + h) * 64 + d) * 128 + v];
#pragma unroll 4
        for (int n_ = 0; n_ < N; ++n_) { const int n = dir ? N - 1 - n_ : n_; const size_t idx = ((size_t)(cbase + n) * 4 + h) * 2 + dir;
            const float u = U[idx * 8192 + e], dc = DECAY[idx * 64 + d];
            SPREV[idx * 8192 + e] = (bf16)f2bf(s); s = dc * s + u; }
        if (!lat) out[(dir ? OUT_SB : OUT_SF) + ((size_t)(b * 4 + h) * 64 + d) * 128 + v] = s;
    }
}
__device__ __forceinline__ void gla_o_item(LAS unsigned char* lds, const bf16* PROJ, const float* w_gk2, const float* b_gk2, const bf16* SPREV, const float* gla_g, bf16* MIX, int item, int tid) {
    const int c = item >> 2, h = item & 3, lane = tid & 63, w = tid >> 6;
    LAS float* GB = (LAS float*)(lds + GL_GB); LAS bf16* A = (LAS bf16*)(lds + GL_A); LAS bf16* BT = (LAS bf16*)(lds + GL_BT); LAS bf16* KT = (LAS bf16*)(lds + GL_KT);
    LAS float* O = (LAS float*)(lds + GL_O);
    gla_gates(lds, PROJ, w_gk2, b_gk2, c, h, tid);
    { const int i = tid >> 3, dg = tid & 7; const bf16* prow = PROJ + (size_t)(64 * c + i) * LDP + h * 64 + dg * 8;
      const v4u qr = *(const v4u*)(prow + C_QG), kr = *(const v4u*)(prow + C_KG);
      v4u qf, qb, kf, kb;
#pragma unroll
      for (int e2 = 0; e2 < 4; ++e2) { const int d = dg * 8 + 2 * e2;
          const float bf0 = GB[i * 65 + d], bf1_ = GB[i * 65 + d + 1], bb0 = GB[(64 + i) * 65 + d], bb1 = GB[(64 + i) * 65 + d + 1];
          const float q0 = bflo(qr[e2]) * 0.125f, q1 = bfhi(qr[e2]) * 0.125f, k0 = bflo(kr[e2]), k1 = bfhi(kr[e2]);
          qf[e2] = pk2(q0 * __expf(bf0), q1 * __expf(bf1_)); qb[e2] = pk2(q0 * __expf(bb0), q1 * __expf(bb1));
          kf[e2] = pk2(k0 * __expf(-bf0), k1 * __expf(-bf1_)); kb[e2] = pk2(k0 * __expf(-bb0), k1 * __expf(-bb1)); }
      *(LAS v4u*)(A + i * GA_S + 64 + dg * 8) = qf; *(LAS v4u*)(A + i * GA_S + 128 + dg * 8) = qb;
      *(LAS v4u*)(KT + i * GK_S + dg * 8) = kf; *(LAS v4u*)(KT + (64 + i) * GK_S + dg * 8) = kb; }
    gla_load_vt(BT, GA_S, PROJ, c, h, tid);
    { const int v = tid >> 2, part = tid & 3;
#pragma unroll
      for (int dir = 0; dir < 2; ++dir) { const bf16* sp = SPREV + ((size_t)item * 2 + dir) * 8192 + v * 64 + part * 16;
          const v4u s0 = *(const v4u*)sp, s1 = *(const v4u*)(sp + 8);
          *(LAS v4u*)(BT + v * GA_S + 64 + dir * 64 + part * 16) = s0; *(LAS v4u*)(BT + v * GA_S + 64 + dir * 64 + part * 16 + 8) = s1; } }
    __syncthreads();
    { const int rt = w & 3, jh = w >> 2; f32x4 sf[2], sb[2];
#pragma unroll
      for (int nt = 0; nt < 2; ++nt) { sf[nt] = (f32x4){0.f, 0.f, 0.f, 0.f}; sb[nt] = sf[nt]; }
#pragma unroll
      for (int ks = 0; ks < 2; ++ks) {
          const bf16x8 af = *(const LAS bf16x8*)(A + (16 * rt + (lane & 15)) * GA_S + 64 + ks * 32 + (lane >> 4) * 8);
          const bf16x8 ab = *(const LAS bf16x8*)(A + (16 * rt + (lane & 15)) * GA_S + 128 + ks * 32 + (lane >> 4) * 8);
#pragma unroll
          for (int nt = 0; nt < 2; ++nt) { const int jr = jh * 32 + 16 * nt + (lane & 15);
              const bf16x8 bfv = *(const LAS bf16x8*)(KT + jr * GK_S + ks * 32 + (lane >> 4) * 8);
              const bf16x8 bbv = *(const LAS bf16x8*)(KT + (64 + jr) * GK_S + ks * 32 + (lane >> 4) * 8);
              sf[nt] = __builtin_amdgcn_mfma_f32_16x16x32_bf16(af, bfv, sf[nt], 0, 0, 0);
              sb[nt] = __builtin_amdgcn_mfma_f32_16x16x32_bf16(ab, bbv, sb[nt], 0, 0, 0); } }
#pragma unroll
      for (int nt = 0; nt < 2; ++nt)
#pragma unroll
          for (int r = 0; r < 4; ++r) { const int i = 16 * rt + (lane >> 4) * 4 + r, j = jh * 32 + 16 * nt + (lane & 15);
              const float p = (j <= i ? sf[nt][r] : 0.f) + (j >= i ? sb[nt][r] : 0.f); A[i * GA_S + j] = (bf16)f2bf(p); } }
    __syncthreads();
    { const int rt = w & 3, ch = w >> 2; f32x4 acc[4];
#pragma unroll
      for (int nt = 0; nt < 4; ++nt) acc[nt] = (f32x4){0.f, 0.f, 0.f, 0.f};
#pragma unroll
      for (int ks = 0; ks < 6; ++ks) { const bf16x8 a = *(const LAS bf16x8*)(A + (16 * rt + (lane & 15)) * GA_S + ks * 32 + (lane >> 4) * 8);
#pragma unroll
          for (int nt = 0; nt < 4; ++nt) { const bf16x8 b = *(const LAS bf16x8*)(BT + (ch * 64 + 16 * nt + (lane & 15)) * GA_S + ks * 32 + (lane >> 4) * 8);
              acc[nt] = __builtin_amdgcn_mfma_f32_16x16x32_bf16(a, b, acc[nt], 0, 0, 0); } }
#pragma unroll
      for (int nt = 0; nt < 4; ++nt)
#pragma unroll
          for (int r = 0; r < 4; ++r) O[(16 * rt + (lane >> 4) * 4 + r) * 132 + ch * 64 + 16 * nt + (lane & 15)] = acc[nt][r]; }
    __syncthreads();
    { const int i = tid >> 3, part = tid & 7; float o[16]; float ss = 0.f;
#pragma unroll
      for (int e = 0; e < 16; ++e) { o[e] = O[i * 132 + part * 16 + e]; ss += o[e] * o[e]; }
      ss += __shfl_xor(ss, 1); ss += __shfl_xor(ss, 2); ss += __shfl_xor(ss, 4);
      const float rstd = 1.0f / sqrtf(ss * (1.f / 128.f) + EPS);
      const bf16* ogp = PROJ + (size_t)(64 * c + i) * LDP + C_OG + h * 128 + part * 16; const v4u g0 = *(const v4u*)ogp, g1 = *(const v4u*)(ogp + 8);
      v4u w0, w1;
#pragma unroll
      for (int e2 = 0; e2 < 4; ++e2) {
          const float ga = bflo(g0[e2]), gb = bfhi(g0[e2]), gc = bflo(g1[e2]), gd = bfhi(g1[e2]);
          w0[e2] = pk2(o[2 * e2] * rstd * gla_g[part * 16 + 2 * e2] * siluf(ga), o[2 * e2 + 1] * rstd * gla_g[part * 16 + 2 * e2 + 1] * siluf(gb));
          w1[e2] = pk2(o[8 + 2 * e2] * rstd * gla_g[part * 16 + 8 + 2 * e2] * siluf(gc), o[8 + 2 * e2 + 1] * rstd * gla_g[part * 16 + 8 + 2 * e2 + 1] * siluf(gd)); }
      bf16* mp = MIX + (size_t)(64 * c + i) * 1024 + h * 128 + part * 16; *(v4u*)mp = w0; *(v4u*)(mp + 8) = w1; }
    __syncthreads();
}
#ifndef MK_N_LAUNCHES
#define MK_N_LAUNCHES 1
#endif
constexpr int NPHASE = 11;
__global__ void __launch_bounds__(NT_BLK, 2) fwd_kernel(Args args) {
    extern __shared__ __attribute__((aligned(16))) unsigned char lds_raw[];
    LAS unsigned char* lds = (LAS unsigned char*)lds_raw;
    const int tid = threadIdx.x, lane = tid & 63, wave = __builtin_amdgcn_readfirstlane(tid >> 6);
    const int G = gridDim.x, gw = blockIdx.x * NWAVES + wave, NGW = G * NWAVES;
    cg::grid_group grid = cg::this_grid();
    unsigned char* ws = args.ws; float* out = args.out;
    const float* x_prompt = args.in[0]; const float* x_sample = args.in[1];
    float* MOD = (float*)(ws + WS_MOD); float* DECAY = (float*)(ws + WS_DECAY);
    bf16* WIN_T = (bf16*)(ws + WS_WIN); bf16* WOUT_T = (bf16*)(ws + WS_WOUT); bf16* W13_T = (bf16*)(ws + WS_W13); bf16* W2_T = (bf16*)(ws + WS_W2);
    bf16* KVK = (bf16*)(ws + WS_KVK); bf16* KVV = (bf16*)(ws + WS_KVV); bf16* XN = (bf16*)(ws + WS_XN); bf16* MIX = (bf16*)(ws + WS_MIX);
    bf16* PROJ = (bf16*)(ws + WS_PROJ); bf16* QB = (bf16*)(ws + WS_QB); bf16* GBUF = (bf16*)(ws + WS_G);
    float* U = (float*)(ws + WS_U); bf16* SPREV = (bf16*)(ws + WS_SPREV);
    const int lo = args.ph_lo, hi = args.ph_hi;
#define IN(k) (lo <= (k) && (k) < hi)
#define SEAM(k) do { if (IN(k) && IN((k) + 1)) grid.sync(); } while (0)

    if (IN(0)) {
        p0_adaln(lds, args.in[6], args.in[7], args.in[8], args.in[9], MOD, tid);
        LAS float* scr = (LAS float*)(lds + wave * 16384);
        constexpr int I_IN = 16 * 73, I_OUT = 16 * 32, I_1 = 16 * 88, I_2 = 44 * 32, NITEMS = I_IN + I_OUT + 2 * I_1 + I_2;
        for (int it = gw; it < NITEMS; it += NGW) {
            int r = it;
            if (r < I_IN) { const int kb = r / 73, nb = r % 73; p0_transpose_item(args.in[12], 1024, NPROJ, WIN_T, 64 * kb, 32 * nb, 32 * nb, scr, lane); continue; } r -= I_IN;
            if (r < I_OUT) { const int kb = r / 32, nb = r % 32; p0_transpose_item(args.in[18], 1024, 1024, WOUT_T, 64 * kb, 32 * nb, 32 * nb, scr, lane); continue; } r -= I_OUT;
            if (r < 2 * I_1) { const int sel = r >= I_1; if (sel) r -= I_1; const int kb = r / 88, nb = r % 88, n0 = 32 * nb;
                p0_transpose_item(args.in[sel ? 20 : 19], 1024, DFF, W13_T, 64 * kb, n0, (n0 >> 7) * 256 + sel * 128 + (n0 & 127), scr, lane); continue; } r -= 2 * I_1;
            { const int kb = r / 32, nb = r % 32; p0_transpose_item(args.in[21], DFF, 1024, W2_T, 64 * kb, 32 * nb, 32 * nb, scr, lane); }
        }
        for (int i = gw * 64 + lane; i < (LDP - NPROJ) * 1024 / 8; i += NGW * 64) ((v4u*)(WIN_T + (size_t)NPROJ * 1024))[i] = (v4u){0u, 0u, 0u, 0u};
        for (int i = gw * 64 + lane; i < 2 * PAST * 128 / 2; i += NGW * 64) { const int b = i / (PAST * 64), rem = i % (PAST * 64);
            const float2 k = ((const float2*)args.in[2])[i], v = ((const float2*)args.in[3])[i];
            const size_t o = ((size_t)MCTX + (size_t)b * KVLAT + TLAT) * 128 + 2 * rem;
            *(unsigned*)(KVK + o) = pk2(k.x, k.y); *(unsigned*)(KVV + o) = pk2(v.x, v.y); }
    }
    SEAM(0);
    if (IN(1)) {
        for (int m = gw; m < MROWS; m += NGW) { const bool lat = m >= MCTX; const float* xr = lat ? x_sample + (size_t)(m - MCTX) * DM : x_prompt + (size_t)m * DM;
            const float* md = MOD + (lat ? 1 + ((m - MCTX) >> 11) : 0) * 6144; norm_mod_row(xr, args.in[10], md, md + 1024, XN + (size_t)m * DM, lane); }
    }
    SEAM(1);
    if (IN(2)) {
        pg8::Gemm g{XN, WIN_T, MROWS, LDP, 1024}; pg8::StaticOrder S; S.init(MROWS, LDP, G, (int)blockIdx.x);
        pg8::EpiStore E{PROJ, LDP};
        pg8::gemm_phase<pg8::EpiStore, pg8::StaticOrder, true, true>(lds, g, S, E);
    }
    SEAM(2);
    if (IN(3)) {
        for (int m = gw; m < MROWS; m += NGW) prep_row(m, PROJ, args.in[16], args.in[17], QB, KVK, KVV, out, lane);
        for (int it = blockIdx.x; it < NITEM; it += G) gla_u_item(lds, PROJ, args.in[13], args.in[14], U, DECAY, it, tid);
    }
    SEAM(3);
    if (IN(4)) {
        gla_scan(U, DECAY, SPREV, args.in[4], args.in[5], out, tid);
        for (int u = blockIdx.x; u < 256; u += G) {
            if (u < 128) { const int b = u >> 6, h = (u >> 3) & 7, qb = u & 7;
                attn_body::attn_unit<8>((long)MCTX + b * TLAT + qb * 256, h, (long)MCTX + b * KVLAT, KVLAT / 64, (const attn_body::bf16*)QB, (const attn_body::bf16*)KVK, (const attn_body::bf16*)KVV, (attn_body::bf16*)(MIX + 512), (char*)lds_raw); }
            else { for (int s = 0; s < 2; ++s) { const int cu = 2 * (u - 128) + s, b = cu >> 3, h = cu & 7;
                attn_body::attn_unit<8>((long)b * TCTX, h, (long)b * TCTX, TCTX / 64, (const attn_body::bf16*)QB, (const attn_body::bf16*)KVK, (const attn_body::bf16*)KVV, (attn_body::bf16*)(MIX + 512), (char*)lds_raw); } }
        }
    }
    SEAM(4);
    if (IN(5)) {
        for (int it = blockIdx.x; it < NITEM; it += G) gla_o_item(lds, PROJ, args.in[13], args.in[14], SPREV, args.in[15], MIX, it, tid);
    }
    SEAM(5);
    if (IN(6)) {
        pg8::Gemm g{MIX, WOUT_T, MROWS, 1024, 1024}; pg8::StaticOrder S; S.init(MROWS, 1024, G, (int)blockIdx.x);
        pg8::EpiResGate E{x_prompt, x_sample, out, MOD + 2 * 1024};
        pg8::gemm_phase<pg8::EpiResGate, pg8::StaticOrder, true, true>(lds, g, S, E);
    }
    SEAM(6);
    if (IN(7)) {
        for (int m = gw; m < MROWS; m += NGW) { const bool lat = m >= MCTX;
            const float* md = MOD + (lat ? 1 + ((m - MCTX) >> 11) : 0) * 6144; norm_mod_row(out + (size_t)m * DM, args.in[11], md + 3 * 1024, md + 4 * 1024, XN + (size_t)m * DM, lane); }
    }
    SEAM(7);
    if (IN(8)) {
        pg8::Gemm g{XN, W13_T, MROWS, 2 * DFF, 1024}; pg8::StaticOrder S; S.init(MROWS, 2 * DFF, G, (int)blockIdx.x);
        pg8::EpiSwiglu E{GBUF, DFF};
        pg8::gemm_phase<pg8::EpiSwiglu, pg8::StaticOrder, true, true>(lds, g, S, E);
    }
    SEAM(8);
    if (IN(9)) {
        pg8::Gemm g{GBUF, W2_T, MROWS, 1024, DFF}; pg8::StaticOrder S; S.init(MROWS, 1024, G, (int)blockIdx.x);
        pg8::EpiResGate E{out, out + (size_t)MCTX * DM, out, MOD + 5 * 1024};
        pg8::gemm_phase<pg8::EpiResGate, pg8::StaticOrder, true, true>(lds, g, S, E);
    }
    SEAM(9);
    if (IN(10)) {
        for (int m = gw; m < MROWS; m += NGW) final_norm_row(out + (size_t)m * DM, args.in[22], lane);
    }
#undef IN
#undef SEAM
}

extern "C" void kernel_launch(void* const* d_in, const int* in_sizes, int n_in, void* d_out, int out_size, void* d_ws, size_t ws_size, hipStream_t stream) {
    static int grid = 0;
    if (grid == 0) {
        if (n_in != 23 || ws_size < WS_END) { fprintf(stderr, "kernel_launch: unexpected inputs (n_in %d, ws %zu)\n", n_in, ws_size); grid = -1; return; }
        int dev = 0, cus = 0, per_cu = 0;
        if (hipGetDevice(&dev) != hipSuccess || hipDeviceGetAttribute(&cus, hipDeviceAttributeMultiprocessorCount, dev) != hipSuccess) { grid = -1; return; }
        if (hipFuncSetAttribute((const void*)fwd_kernel, hipFuncAttributeMaxDynamicSharedMemorySize, LDS_BYTES) != hipSuccess) { fprintf(stderr, "kernel_launch: hipFuncSetAttribute failed\n"); grid = -1; return; }
        if (hipOccupancyMaxActiveBlocksPerMultiprocessor(&per_cu, (const void*)fwd_kernel, NT_BLK, LDS_BYTES) != hipSuccess || per_cu < 1) { fprintf(stderr, "kernel_launch: occupancy query says %d\n", per_cu); per_cu = 1; }
        (void)hipGetLastError();
        grid = cus;
    }
    if (grid < 0) return;
    Args a{};
    for (int i = 0; i < 23; ++i) a.in[i] = (const float*)d_in[i];
    a.out = (float*)d_out; a.ws = (unsigned char*)d_ws;
    if (MK_N_LAUNCHES == 1) {
        a.ph_lo = 0; a.ph_hi = NPHASE;
        void* kargs[] = {&a};
        hipError_t e = hipLaunchCooperativeKernel((const void*)fwd_kernel, dim3(grid), dim3(NT_BLK), kargs, LDS_BYTES, stream);
        if (e != hipSuccess) fprintf(stderr, "kernel_launch: cooperative launch failed: %s (grid %d)\n", hipGetErrorString(e), grid);
    } else {
        for (int ph = 0; ph < NPHASE; ++ph) { a.ph_lo = ph; a.ph_hi = ph + 1; hipLaunchKernelGGL(fwd_kernel, dim3(grid), dim3(NT_BLK), LDS_BYTES, stream, a); }
    }
}
```

```cpp
#include <hip/hip_runtime.h>
#include <hip/hip_cooperative_groups.h>
#include <hip/hip_bf16.h>
#include <cstdio>
#include <cstdint>
#include <cmath>
namespace cg = cooperative_groups;
namespace pg8 {
#define PG8_LAS __attribute__((address_space(3)))
typedef unsigned short bf16_t;
typedef short bf16x8 __attribute__((ext_vector_type(8)));
typedef float f32x4 __attribute__((ext_vector_type(4)));
typedef unsigned u32x4 __attribute__((ext_vector_type(4)));
constexpr int BM = 256, BK = 64, HALF = 128, HTB = HALF * BK * 2  , STAGE_BYTES = 8 * HTB, NXCD = 8, WGM = 8;

__host__ __device__ __forceinline__ int lds_byte(int r, int c) { const int st = (r >> 4) * 2 + (c >> 5), rr = r & 15, cc = c & 31, ob = rr * 64 + cc * 2; return st * 1024 + (ob ^ (((ob >> 9) & 1) << 5)); }
__host__ __device__ __forceinline__ void stage_rc(int b, int& R, int& C) { const int st = b / 1024, sb = b % 1024, swz = sb ^ (((sb >> 9) & 1) << 5); R = (st >> 1) * 16 + swz / 64; C = (st & 1) * 32 + (swz % 64) / 2; }
__host__ __device__ __forceinline__ int perm32(int rho) { const int n = rho >> 4, i = rho & 15; return 8 * (i >> 2) + 4 * n + (i & 3); }

struct Unit { int pm, pn; };
struct Gemm { const bf16_t* A; const bf16_t* Bt; int M, N, K; };

struct StaticOrder {
    int nM, nN, nwg, G, c;
    __host__ __device__ void init(int M, int N, int G_, int c_) { nM = M / BM; nN = N / BM; nwg = nM * nN; G = G_; c = c_; }
    __host__ __device__ bool next(int i, Unit& u) const {
        const long L = (long)i * G + c; if (L >= nwg) return false;
        int wgid = (int)L; { const int q = nwg / NXCD, r = nwg % NXCD, xcd = wgid % NXCD, off = wgid / NXCD; wgid = (xcd < r ? xcd * (q + 1) : r * (q + 1) + (xcd - r) * q) + off; }
        const int nig = WGM * nN, gid = wgid / nig, fm = gid * WGM, gsz = (nM - fm) < WGM ? (nM - fm) : WGM;
        u.pm = fm + ((wgid % nig) % gsz); u.pn = (wgid % nig) / gsz; return true;
    }
    __device__ __forceinline__ void a_ready(const Unit&) const {}
    __device__ __forceinline__ void done(const Unit&) const {}
};

__device__ __forceinline__ unsigned cvt_pk_bf16(float lo, float hi) { unsigned r; asm volatile("v_cvt_pk_bf16_f32 %0, %1, %2" : "=v"(r) : "v"(lo), "v"(hi)); return r; }
struct EpiStore {
    static constexpr bool PERM = true, AFTER_DRAIN = false;
    bf16_t* O; int ldc;
    __device__ __forceinline__ void operator()(const f32x4 (&acc)[2][2][4][2], const Unit& u, int wr, int wc, int fr, int fq) const {
        const int row0 = u.pm * BM + wr * 64 + fr, col0 = u.pn * BM + wc * 32 + 8 * fq;
#pragma unroll
        for (int ai = 0; ai < 2; ++ai)
#pragma unroll
            for (int m = 0; m < 4; ++m) { bf16_t* rowp = O + (size_t)(row0 + ai * HALF + m * 16) * ldc + col0;
#pragma unroll
                for (int bj = 0; bj < 2; ++bj) { const f32x4 v0 = acc[ai][bj][m][0], v1 = acc[ai][bj][m][1];
                    u32x4 w; w.x = cvt_pk_bf16(v0[0], v0[1]); w.y = cvt_pk_bf16(v0[2], v0[3]); w.z = cvt_pk_bf16(v1[0], v1[1]); w.w = cvt_pk_bf16(v1[2], v1[3]);
                    *(u32x4*)(rowp + bj * HALF) = w; } }
    }
};
struct EpiSwiglu {
    static constexpr bool PERM = true, AFTER_DRAIN = false;
    bf16_t* O; int ldc;
    __device__ __forceinline__ void operator()(const f32x4 (&acc)[2][2][4][2], const Unit& u, int wr, int wc, int fr, int fq) const {
        const int row0 = u.pm * BM + wr * 64 + fr, col0 = u.pn * HALF + wc * 32 + 8 * fq;
#pragma unroll
        for (int ai = 0; ai < 2; ++ai)
#pragma unroll
            for (int m = 0; m < 4; ++m) { bf16_t* rowp = O + (size_t)(row0 + ai * HALF + m * 16) * ldc + col0;
                float g[8];
#pragma unroll
                for (int n = 0; n < 2; ++n)
#pragma unroll
                    for (int e = 0; e < 4; ++e) { const float a = acc[ai][0][m][n][e], b = acc[ai][1][m][n][e]; g[n * 4 + e] = a * __builtin_amdgcn_rcpf(1.0f + __expf(-a)) * b; }
                u32x4 w; w.x = cvt_pk_bf16(g[0], g[1]); w.y = cvt_pk_bf16(g[2], g[3]); w.z = cvt_pk_bf16(g[4], g[5]); w.w = cvt_pk_bf16(g[6], g[7]);
                *(u32x4*)rowp = w; }
    }
};
struct EpiResGate {
    static constexpr bool PERM = false, AFTER_DRAIN = false;
    const float* base0; const float* base1; float* out; const float* gate;
    __device__ __forceinline__ void operator()(const f32x4 (&acc)[2][2][4][2], const Unit& u, int wr, int wc, int fr, int fq) const {
        const int rt = u.pm * BM; const bool lat = rt >= 8192;
        const float* bs = lat ? base1 - (size_t)8192 * 1024 : base0;
        const float* gt = gate + (lat ? 1 + ((rt - 8192) >> 11) : 0) * 6144;
        const int col0 = u.pn * BM + wc * 32 + 4 * fq;
#pragma unroll
        for (int bj = 0; bj < 2; ++bj)
#pragma unroll
            for (int n = 0; n < 2; ++n) { const int col = col0 + bj * HALF + n * 16; const f32x4 gv = *(const f32x4*)(gt + col);
#pragma unroll
                for (int ai = 0; ai < 2; ++ai)
#pragma unroll
                    for (int m = 0; m < 4; ++m) { const size_t off = (size_t)(rt + ai * HALF + wr * 64 + m * 16 + fr) * 1024 + col;
                        const f32x4 b = *(const f32x4*)(bs + off); *(f32x4*)(out + off) = b + gv * acc[ai][bj][m][n]; } }
    }
};
template <class Epi, class Sched, bool ALIGN_EPI = false, bool SP2 = false>
__device__ __forceinline__ void gemm_phase(PG8_LAS unsigned char* lds, const Gemm g, const Sched& S, const Epi& E) {
    const int tid = threadIdx.x, wid = __builtin_amdgcn_readfirstlane(tid >> 6), lane = tid & 63, wr = wid >> 2, wc = wid & 3, fr = lane & 15, fq = lane >> 4;
    const int K = g.K, nt = K / BK;
    unsigned voffA[2], voffB[2];
#pragma unroll
    for (int i = 0; i < 2; ++i) { int R, C; stage_rc(tid * 16 + i * 8192, R, C); const int Rb = Epi::PERM ? ((R & ~31) + perm32(R & 31)) : R;
        voffA[i] = (unsigned)(R * K + C) * 2u; voffB[i] = (unsigned)(Rb * K + C) * 2u; }
    const size_t kstep = (size_t)(BK * 2);
    const size_t hstep = (size_t)HALF * K * 2;
    const size_t tstep = 2 * hstep;
    const unsigned ldsw = (unsigned)wid * 1024u;
    const int aoff = lds_byte(wr * 64 + fr, fq * 8), boff = lds_byte(wc * 32 + fr, fq * 8);
#define PG8_SA(b, h) (((b) * 2 + (h)) * HTB)
#define PG8_SB(b, h) ((4 + (b) * 2 + (h)) * HTB)
#define PG8_STAGE(bufoff, gbase, voff) do { _Pragma("unroll") for (int _i = 0; _i < 2; ++_i) \
        __builtin_amdgcn_global_load_lds((const unsigned*)((const char*)(gbase) + (voff)[_i]), (PG8_LAS unsigned*)(lds + (bufoff) + ldsw + _i * 8192), 16, 0, 0); } while (0)
#define PG8_LDA(dst, b, h) do { _Pragma("unroll") for (int m = 0; m < 4; ++m) _Pragma("unroll") for (int k = 0; k < 2; ++k) dst[m][k] = *(const PG8_LAS bf16x8*)(lds + PG8_SA(b, h) + aoff + m * 2048 + k * 1024); } while (0)
#define PG8_LDB(dst, b, h) do { _Pragma("unroll") for (int n = 0; n < 2; ++n) _Pragma("unroll") for (int k = 0; k < 2; ++k) dst[n][k] = *(const PG8_LAS bf16x8*)(lds + PG8_SB(b, h) + boff + n * 2048 + k * 1024); } while (0)
#define PG8_MMA(ai, bj, At, Bt) do { __builtin_amdgcn_s_setprio(1); _Pragma("unroll") for (int m = 0; m < 4; ++m) _Pragma("unroll") for (int n = 0; n < 2; ++n) _Pragma("unroll") for (int k = 0; k < 2; ++k) \
        acc[ai][bj][m][n] = __builtin_amdgcn_mfma_f32_16x16x32_bf16(Bt[n][k], At[m][k], acc[ai][bj][m][n], 0, 0, 0); __builtin_amdgcn_s_setprio(0); } while (0)
#define PG8_WAIT_V(n) asm volatile("s_waitcnt vmcnt(" #n ")" ::: "memory")
#define PG8_WAIT_L(n) asm volatile("s_waitcnt lgkmcnt(" #n ")" ::: "memory")
#define PG8_BAR __builtin_amdgcn_s_barrier()
#define PG8_SCHED __builtin_amdgcn_sched_barrier(0)
    Unit cur, nxt; int ui = 0;
    if (!S.next(0, cur)) return;
    f32x4 acc[2][2][4][2];
#pragma unroll
    for (int a = 0; a < 2; ++a)
#pragma unroll
        for (int b = 0; b < 2; ++b)
#pragma unroll
            for (int m = 0; m < 4; ++m)
#pragma unroll
                for (int n = 0; n < 2; ++n) acc[a][b][m][n] = (f32x4){0.f, 0.f, 0.f, 0.f};
    bf16x8 At[4][2], B0[2][2], B1[2][2];
    const char* cA = (const char*)g.A + (size_t)cur.pm * tstep; const char* cB = (const char*)g.Bt + (size_t)cur.pn * tstep;
    S.a_ready(cur);
    if constexpr (SP2) {
        PG8_STAGE(PG8_SB(0, 0), cB, voffB); PG8_STAGE(PG8_SB(0, 1), cB + hstep, voffB); PG8_STAGE(PG8_SA(0, 0), cA, voffA); PG8_STAGE(PG8_SA(0, 1), cA + hstep, voffA);
        if (wr == 1) PG8_BAR;
        PG8_WAIT_V(2); PG8_BAR;
        PG8_STAGE(PG8_SB(1, 0), cB + kstep, voffB); PG8_STAGE(PG8_SA(1, 0), cA + kstep, voffA); PG8_STAGE(PG8_SB(1, 1), cB + hstep + kstep, voffB);
        PG8_WAIT_V(6); PG8_BAR;
    } else {
        PG8_STAGE(PG8_SB(0, 0), cB, voffB); PG8_STAGE(PG8_SA(0, 0), cA, voffA); PG8_STAGE(PG8_SB(0, 1), cB + hstep, voffB); PG8_STAGE(PG8_SA(0, 1), cA + hstep, voffA);
        if (wr == 1) PG8_BAR;
        PG8_WAIT_V(4); PG8_BAR;
        PG8_STAGE(PG8_SB(1, 0), cB + kstep, voffB); PG8_STAGE(PG8_SA(1, 0), cA + kstep, voffA); PG8_STAGE(PG8_SB(1, 1), cB + hstep + kstep, voffB);
        PG8_WAIT_V(6); PG8_BAR;
    }
    for (;;) {
        const bool has_next = S.next(ui + 1, nxt);
        const char* nA = has_next ? (const char*)g.A + (size_t)nxt.pm * tstep : cA; const char* nB = has_next ? (const char*)g.Bt + (size_t)nxt.pn * tstep : cB;
        for (int t = 0; t < nt; t += 2) {
            const bool last = (t == nt - 2);
            const char* a1 = cA + (size_t)(t + 1) * kstep;
            const char* a2 = last ? nA : cA + (size_t)(t + 2) * kstep; const char* b2 = last ? nB : cB + (size_t)(t + 2) * kstep;
            const char* a3 = a2 + kstep; const char* b3 = b2 + kstep;
            if (last && has_next) S.a_ready(nxt);
            if constexpr (SP2) {
            PG8_LDB(B0, 0, 0); PG8_LDB(B1, 0, 1); PG8_SCHED; PG8_LDA(At, 0, 0); PG8_STAGE(PG8_SA(1, 1), a1 + hstep, voffA);
            PG8_WAIT_V(8); PG8_WAIT_L(0); PG8_BAR; PG8_MMA(0, 0, At, B0); PG8_MMA(0, 1, At, B1); PG8_BAR; PG8_SCHED;
            PG8_LDA(At, 0, 1); PG8_STAGE(PG8_SB(0, 0), b2, voffB); PG8_STAGE(PG8_SB(0, 1), b2 + hstep, voffB); PG8_STAGE(PG8_SA(0, 0), a2, voffA);
            PG8_WAIT_V(8); PG8_WAIT_L(0); PG8_BAR; PG8_MMA(1, 0, At, B0); PG8_MMA(1, 1, At, B1); PG8_BAR; PG8_SCHED;
            PG8_LDB(B0, 1, 0); PG8_LDB(B1, 1, 1); PG8_SCHED; PG8_LDA(At, 1, 0); PG8_STAGE(PG8_SA(0, 1), a2 + hstep, voffA);
            PG8_WAIT_V(8); PG8_WAIT_L(0); PG8_BAR; PG8_MMA(0, 0, At, B0); PG8_MMA(0, 1, At, B1); PG8_BAR; PG8_SCHED;
            PG8_LDA(At, 1, 1); PG8_STAGE(PG8_SB(1, 0), b3, voffB); PG8_STAGE(PG8_SB(1, 1), b3 + hstep, voffB); PG8_STAGE(PG8_SA(1, 0), a3, voffA);
            PG8_WAIT_V(8); PG8_WAIT_L(0); PG8_BAR; PG8_MMA(1, 0, At, B0); PG8_MMA(1, 1, At, B1); PG8_BAR; PG8_SCHED;
            } else {
            PG8_LDB(B0, 0, 0); PG8_SCHED; PG8_LDA(At, 0, 0); PG8_STAGE(PG8_SA(1, 1), a1 + hstep, voffA);
            PG8_WAIT_L(8); PG8_BAR; PG8_WAIT_L(0); PG8_MMA(0, 0, At, B0); PG8_BAR; PG8_SCHED;
            PG8_LDB(B1, 0, 1); PG8_STAGE(PG8_SB(0, 0), b2, voffB);
            PG8_BAR; PG8_WAIT_L(0); PG8_MMA(0, 1, At, B1); PG8_BAR;
            PG8_LDA(At, 0, 1); PG8_STAGE(PG8_SA(0, 0), a2, voffA);
            PG8_BAR; PG8_WAIT_L(0); PG8_MMA(1, 0, At, B0); PG8_BAR; PG8_SCHED;
            PG8_STAGE(PG8_SB(0, 1), b2 + hstep, voffB);
            PG8_WAIT_V(6); PG8_BAR; PG8_MMA(1, 1, At, B1); PG8_BAR;
            PG8_LDB(B0, 1, 0); PG8_SCHED; PG8_LDA(At, 1, 0); PG8_STAGE(PG8_SA(0, 1), a2 + hstep, voffA);
            PG8_WAIT_L(8); PG8_BAR; PG8_WAIT_L(0); PG8_MMA(0, 0, At, B0); PG8_BAR; PG8_SCHED;
            PG8_LDB(B1, 1, 1); PG8_STAGE(PG8_SB(1, 0), b3, voffB);
            PG8_BAR; PG8_WAIT_L(0); PG8_MMA(0, 1, At, B1); PG8_BAR;
            PG8_LDA(At, 1, 1); PG8_STAGE(PG8_SA(1, 0), a3, voffA);
            PG8_BAR; PG8_WAIT_L(0); PG8_MMA(1, 0, At, B0); PG8_BAR; PG8_SCHED;
            PG8_STAGE(PG8_SB(1, 1), b3 + hstep, voffB);
            PG8_WAIT_V(6); PG8_BAR; PG8_MMA(1, 1, At, B1); PG8_BAR;
            }
        }
        if constexpr (ALIGN_EPI) { if (wr == 0) PG8_BAR; }
        if constexpr (!Epi::AFTER_DRAIN) { E(acc, cur, wr, wc, fr, fq); S.done(cur); }
        if (!has_next) break;
#pragma unroll
        for (int a = 0; a < 2; ++a)
#pragma unroll
            for (int b = 0; b < 2; ++b)
#pragma unroll
                for (int m = 0; m < 4; ++m)
#pragma unroll
                    for (int n = 0; n < 2; ++n) acc[a][b][m][n] = (f32x4){0.f, 0.f, 0.f, 0.f};
        cur = nxt; cA = nA; cB = nB; ++ui;
        if constexpr (ALIGN_EPI) { if (wr == 1) PG8_BAR; }
    }
    PG8_WAIT_V(0);
    if constexpr (!ALIGN_EPI) { if (wr == 0) PG8_BAR; }
    PG8_BAR;
    if constexpr (Epi::AFTER_DRAIN) { E.fused(acc, cur, wr, wc, fr, fq, lds, wid, lane); S.done(cur); }
#undef PG8_SA
#undef PG8_SB
#undef PG8_STAGE
#undef PG8_LDA
#undef PG8_LDB
#undef PG8_MMA
#undef PG8_WAIT_V
#undef PG8_WAIT_L
#undef PG8_BAR
#undef PG8_SCHED
}
}
#include <hip/hip_bf16.h>
#include <cmath>
namespace attn_body {
using bf16=__hip_bfloat16;
using bf16x8=__attribute__((ext_vector_type(8)))short;
using s16x4=__attribute__((ext_vector_type(4)))short;
using f32x16=__attribute__((ext_vector_type(16)))float;
using u32x4=__attribute__((ext_vector_type(4)))unsigned;
constexpr int D=64,QP=512,KP=128,OP=1024;
constexpr int NW=8,QBLK=32,QB=QBLK*NW,KVBLK=64;
constexpr int ATTN_UNIT_ROWS=QB;
__device__ __forceinline__ int crow(int r,int hi){return (r&3)+8*(r>>2)+4*hi;}
#define SBAR() __builtin_amdgcn_sched_barrier(0)
__device__ __forceinline__ void cmask(f32x16&p0,f32x16&p1,int jb,int qrel,int hi){
  const float NEG=-INFINITY; int kb=64*jb+4*hi;
  #pragma unroll
  for(int r=0;r<16;++r){int kv=kb+(r&3)+8*(r>>2); if(kv>qrel)p0[r]=NEG; if(kv+32>qrel)p1[r]=NEG;}
}

constexpr int NSLOT=3, SLOTB=8192;
constexpr int LDS_K=0, LDS_V=NSLOT*SLOTB, LDS_WS=2*NSLOT*SLOTB, LDS_OST=LDS_WS+NW*64*4, LDS_BYTES=LDS_OST+NW*4096;
constexpr float C2=0.125f*1.4426950408889634f;
__device__ __forceinline__ void glds16(const void*gsrc,unsigned lds_dst){unsigned keep;
  asm volatile("s_mov_b32 %0, m0\n\ts_mov_b32 m0, %2\n\ts_nop 0\n\tglobal_load_lds_dwordx4 %1, off\n\ts_mov_b32 m0, %0":"=&s"(keep):"v"(gsrc),"s"(lds_dst):"memory");}
__device__ __forceinline__ float max3f(float a,float b,float c){float r;asm("v_max3_f32 %0, %1, %2, %3":"=v"(r):"v"(a),"v"(b),"v"(c));return r;}
__device__ __forceinline__ float max2f(float a,float b){float r;asm("v_max_f32_e32 %0, %1, %2":"=v"(r):"v"(a),"v"(b));return r;}
__device__ __forceinline__ float fadd_s(float a,float b){float r;asm("v_add_f32_e32 %0, %1, %2":"=v"(r):"v"(a),"v"(b));return r;}
__device__ __forceinline__ float fsub_s(float a,float b){float r;asm("v_sub_f32_e32 %0, %1, %2":"=v"(r):"v"(a),"v"(b));return r;}
typedef float f32x2_t __attribute__((ext_vector_type(2))); typedef __bf16 bf16x2_t __attribute__((ext_vector_type(2)));
__device__ __forceinline__ unsigned cvtpk_s(float lo,float hi){f32x2_t v={lo,hi};bf16x2_t b=__builtin_convertvector(v,bf16x2_t);return __builtin_bit_cast(unsigned,b);}
#define WAIT_BAR(N) asm volatile("s_waitcnt vmcnt(" #N ") lgkmcnt(0)\n\ts_barrier":::"memory")

__device__ __forceinline__ void qkt(f32x16&p0,f32x16&p1,const char*Kslot,const bf16x8*qr,const f32x16&negm,int r32,int hi){
  const char*kb=Kslot+hi*1024+r32*16;
  #pragma unroll
  for(int d0=0;d0<4;++d0){
    const bf16x8 b0=*reinterpret_cast<const bf16x8*>(kb+d0*2048);
    const bf16x8 b1=*reinterpret_cast<const bf16x8*>(kb+d0*2048+512);
    if(d0==0){p0=__builtin_amdgcn_mfma_f32_32x32x16_bf16(b0,qr[0],negm,0,0,0);p1=__builtin_amdgcn_mfma_f32_32x32x16_bf16(b1,qr[0],negm,0,0,0);}
    else{p0=__builtin_amdgcn_mfma_f32_32x32x16_bf16(b0,qr[d0],p0,0,0,0);p1=__builtin_amdgcn_mfma_f32_32x32x16_bf16(b1,qr[d0],p1,0,0,0);}}
}
typedef __attribute__((address_space(3))) const char* lds_cptr;
typedef short v4i16_t __attribute__((ext_vector_type(4)));
__device__ __forceinline__ void kload8(bf16x8*kf,lds_cptr kp){
  kf[0]=*(const __attribute__((address_space(3))) bf16x8*)(kp);      kf[1]=*(const __attribute__((address_space(3))) bf16x8*)(kp+512);
  kf[2]=*(const __attribute__((address_space(3))) bf16x8*)(kp+2048); kf[3]=*(const __attribute__((address_space(3))) bf16x8*)(kp+2560);
  kf[4]=*(const __attribute__((address_space(3))) bf16x8*)(kp+4096); kf[5]=*(const __attribute__((address_space(3))) bf16x8*)(kp+4608);
  kf[6]=*(const __attribute__((address_space(3))) bf16x8*)(kp+6144); kf[7]=*(const __attribute__((address_space(3))) bf16x8*)(kp+6656);
}
__device__ __forceinline__ void kload2(bf16x8*kf,lds_cptr kp,int j){ kf[2*j]=*(const __attribute__((address_space(3))) bf16x8*)(kp+j*2048); kf[2*j+1]=*(const __attribute__((address_space(3))) bf16x8*)(kp+j*2048+512); }
__device__ __forceinline__ s16x4 vtr(lds_cptr p){ return __builtin_bit_cast(s16x4,__builtin_amdgcn_ds_read_tr16_b64_v4i16((__attribute__((address_space(3))) v4i16_t*)p)); }
__device__ __forceinline__ float rowmax(const f32x16&p0,const f32x16&p1){
  float a=max3f(p0[0],p0[1],p1[0]),b=max3f(p0[2],p0[3],p1[1]);a=max3f(a,p1[2],p1[3]);
  #pragma unroll
  for(int r=4;r<16;r+=4){a=max3f(a,p0[r],p0[r+1]);b=max3f(b,p0[r+2],p0[r+3]);a=max3f(a,p1[r],p1[r+1]);b=max3f(b,p1[r+2],p1[r+3]);}
  const float m=max2f(a,b);
  auto rr=__builtin_amdgcn_permlane32_swap(__float_as_uint(m),__float_as_uint(m),false,false);
  return max2f(__uint_as_float(rr[0]),__uint_as_float(rr[1]));
}
__device__ __forceinline__ void pv(f32x16*o,int vb,bf16x8 pa0,bf16x8 pa1,bf16x8 pa2,bf16x8 pa3){
  #pragma unroll
  for(int d0=0;d0<2;++d0){s16x4 lo[4],hi[4];
    #pragma unroll
    for(int ks=0;ks<4;++ks){
      asm volatile("ds_read_b64_tr_b16 %0,%1 offset:%c2":"=&v"(lo[ks]):"v"(vb),"i"(d0*4096+ks*1024):"memory");
      asm volatile("ds_read_b64_tr_b16 %0,%1 offset:%c2":"=&v"(hi[ks]):"v"(vb),"i"(d0*4096+ks*1024+512):"memory");}
    asm volatile("s_waitcnt lgkmcnt(0)":::"memory");SBAR();
    #define PK(k) (bf16x8){lo[k][0],lo[k][1],lo[k][2],lo[k][3],hi[k][0],hi[k][1],hi[k][2],hi[k][3]}
    o[d0]=__builtin_amdgcn_mfma_f32_32x32x16_bf16(pa0,PK(0),o[d0],0,0,0);
    o[d0]=__builtin_amdgcn_mfma_f32_32x32x16_bf16(pa1,PK(1),o[d0],0,0,0);
    o[d0]=__builtin_amdgcn_mfma_f32_32x32x16_bf16(pa2,PK(2),o[d0],0,0,0);
    o[d0]=__builtin_amdgcn_mfma_f32_32x32x16_bf16(pa3,PK(3),o[d0],0,0,0);
    #undef PK
  }
}

#ifndef ATTN_STORE16
#define ATTN_STORE16(p,v) (*(u32x4*)(p)=(v))
#endif
template<int THRL> __device__ __forceinline__ void attn_unit(long qrow0,int h,long kvrow0,int NT,const bf16*Q,const bf16*__restrict__ K,const bf16*__restrict__ V,bf16*O,char*shm){
  const int tid=threadIdx.x,lane=tid&63,r32=lane&31,hi=lane>>5; const int wid=__builtin_amdgcn_readfirstlane(tid>>6);
  const bf16*Qw=Q+(qrow0+wid*QBLK)*QP+h*D;
  const bf16*Kh=K+kvrow0*KP+(h>>2)*D,*Vh=V+kvrow0*KP+(h>>2)*D;
  const unsigned lds0=(unsigned)(uintptr_t)shm;
  float*wsf=(float*)(shm+LDS_WS)+wid*64;
  const bf16*ksrc=Kh+(long)lane*KP+wid*8;
  const bf16*vsrc=Vh+(long)(16*(wid&3)+(lane>>2))*KP+(wid>>2)*32+(lane&3)*8;
  const unsigned kdst=lds0+LDS_K+wid*1024, vdst=lds0+LDS_V+wid*1024;
  #define DMA_K(t,slot) glds16(ksrc+(long)(t)*KVBLK*KP,(unsigned)__builtin_amdgcn_readfirstlane(kdst+(slot)))
  #define DMA_V(t,slot) glds16(vsrc+(long)(t)*KVBLK*KP,(unsigned)__builtin_amdgcn_readfirstlane(vdst+(slot)))
  const int vb0=(int)(lds0+LDS_V)+((lane>>4)&1)*32+(lane&3)*8+(4*hi+((lane&15)>>2))*64;
  const char*Kbase=shm+LDS_K; bf16x8 kf[8];
  const lds_cptr shm3=(lds_cptr)shm; const lds_cptr kp0=shm3+LDS_K+hi*1024+r32*16; const lds_cptr vp0=shm3+LDS_V+((lane>>4)&1)*32+(lane&3)*8+(4*hi+((lane&15)>>2))*64;
  DMA_K(0,0);DMA_V(0,0);DMA_K(1,SLOTB);
  bf16x8 qr[4];
  #pragma unroll
  for(int d0=0;d0<4;++d0)qr[d0]=*reinterpret_cast<const bf16x8*>(&Qw[(long)r32*QP+d0*16+hi*8]);
  float mhat=0.f,l_reg=0.f;f32x16 o[2];o[0]=f32x16{};o[1]=f32x16{};f32x16 negm=f32x16{};asm volatile("":"+v"(negm));
  (void)0;
  #define CMASK(P0,P1,t) do{}while(0)
  bool resc=false;
  #define START(P0,P1) do{ const float rm=rowmax(P0,P1); resc=false; \
    { const float dl=rm; mhat=fadd_s(mhat,dl); \
      _Pragma("unroll") for(int r=0;r<16;++r){P0[r]=fsub_s(P0[r],dl);P1[r]=fsub_s(P1[r],dl);} \
      _Pragma("unroll") for(int r=0;r<16;++r)negm[r]=-mhat; asm volatile("":"+v"(negm)); } \
    _Pragma("unroll") for(int r=0;r<16;++r)P0[r]=__builtin_amdgcn_exp2f(P0[r]); }while(0)
  #define RESC() do{ if(resc){ asm volatile("s_waitcnt lgkmcnt(0)":::"memory"); \
      _Pragma("unroll") for(int d_=0;d_<2;++d_) _Pragma("unroll") for(int r=0;r<16;++r)o[d_][r]*=wsf[crow(r,hi)]; } }while(0)
  f32x16 pA0,pA1,pB0,pB1;
  int sl_prev=0,sl_cur=0,sl_next=SLOTB;
  #define ROT() do{sl_prev=sl_cur;sl_cur=sl_next;sl_next=(sl_next==(NSLOT-1)*SLOTB)?0:sl_next+SLOTB;}while(0)
  DMA_K(2,2*SLOTB);
  WAIT_BAR(3);
  qkt(pA0,pA1,Kbase,qr,negm,r32,hi);asm volatile("s_nop 15\n\ts_nop 7":"+v"(pA0),"+v"(pA1));CMASK(pA0,pA1,0);
  START(pA0,pA1);
  _Pragma("unroll") for(int r=0;r<16;++r)pA1[r]=__builtin_amdgcn_exp2f(pA1[r]);
  WAIT_BAR(0);
  DMA_K(3,0);DMA_V(1,SLOTB);
  ROT();
  kload8(kf,kp0+sl_cur);
  WAIT_BAR(2);
  s16x4 vlo[8],vhi[8]; u32x4 pw0,pw1,pw2,pw3;
  #define PKW(P,B) cvtpk_s(P[B],P[B+1])
  #define PAF(k) __builtin_bit_cast(bf16x8,pw##k)
  #define VFR(i) (bf16x8){vlo[i][0],vlo[i][1],vlo[i][2],vlo[i][3],vhi[i][0],vhi[i][1],vhi[i][2],vhi[i][3]}
  #define PIN(x) asm volatile("":"+v"(x))
  #define MX3(a,b,c) __builtin_fmaxf(__builtin_fmaxf((a),(b)),(c))
  #define GAPA(MF,A0,A1,A2,A3,W0,W1,PW) do{ MF; sacc+=A0; sacc+=A1; sacc+=A2; sacc+=A3; PIN(sacc); W0; W1; PIN(PW); SBAR(); }while(0)
  #define EX(v) __builtin_amdgcn_exp2f(v)
  #define GAPB(MF,X,B) do{ MF; X[B]=EX(X[B]); X[B+1]=EX(X[B+1]); X[B+2]=EX(X[B+2]); X[B+3]=EX(X[B+3]); PIN(X); SBAR(); }while(0)
  #define VRD(i) do{ vlo[i]=vtr(vp_+(((i)>>2)*4096+((i)&3)*1024)); vhi[i]=vtr(vp_+(((i)>>2)*4096+((i)&3)*1024+512)); }while(0)
  #define KRD(G,j) do{ if(G){ kload2(kf,kp0+sl_next,j); SBAR(); } }while(0)
  #define STEP(C0,C1,P0,P1,t,GK,GV,GL) do{ SBAR(); \
    const lds_cptr vp_=vp0+sl_prev; \
    VRD(0); SBAR(); float sacc=(P0[0]+P0[1]); \
    GAPA(C0=__builtin_amdgcn_mfma_f32_32x32x16_bf16(kf[0],qr[0],negm,0,0,0), P0[2],P0[3],P0[4],P0[5],     pw0[0]=PKW(P0,0), pw0[1]=PKW(P0,2), pw0); \
    VRD(4); SBAR(); GAPA(C1=__builtin_amdgcn_mfma_f32_32x32x16_bf16(kf[1],qr[0],negm,0,0,0), P0[6],P0[7],P0[8],P0[9],     pw0[2]=PKW(P0,4), pw0[3]=PKW(P0,6), pw0); \
    VRD(1); SBAR(); GAPA(C0=__builtin_amdgcn_mfma_f32_32x32x16_bf16(kf[2],qr[1],C0,0,0,0),   P0[10],P0[11],P0[12],P0[13], pw1[0]=PKW(P0,8), pw1[1]=PKW(P0,10), pw1); \
    VRD(5); SBAR(); GAPA(C1=__builtin_amdgcn_mfma_f32_32x32x16_bf16(kf[3],qr[1],C1,0,0,0),   P0[14],P0[15],P1[0],P1[1],   pw1[2]=PKW(P0,12),pw1[3]=PKW(P0,14), pw1); \
    VRD(2); SBAR(); GAPA(C0=__builtin_amdgcn_mfma_f32_32x32x16_bf16(kf[4],qr[2],C0,0,0,0),   P1[2],P1[3],P1[4],P1[5],     pw2[0]=PKW(P1,0), pw2[1]=PKW(P1,2), pw2); \
    VRD(6); SBAR(); GAPA(C1=__builtin_amdgcn_mfma_f32_32x32x16_bf16(kf[5],qr[2],C1,0,0,0),   P1[6],P1[7],P1[8],P1[9],     pw2[2]=PKW(P1,4), pw2[3]=PKW(P1,6), pw2); \
    VRD(3); SBAR(); GAPA(C0=__builtin_amdgcn_mfma_f32_32x32x16_bf16(kf[6],qr[3],C0,0,0,0),   P1[10],P1[11],P1[12],P1[13], pw3[0]=PKW(P1,8), pw3[1]=PKW(P1,10), pw3); \
    VRD(7); SBAR(); GAPA(C1=__builtin_amdgcn_mfma_f32_32x32x16_bf16(kf[7],qr[3],C1,0,0,0),   P1[14],P1[15],0.f,0.f,       pw3[2]=PKW(P1,12),pw3[3]=PKW(P1,14), pw3); \
    l_reg+=sacc; \
    if(GK){DMA_K((t)+3,sl_cur);} if(GV){DMA_V((t)+1,sl_next);} \
    CMASK(C0,C1,t); \
    { float a=MX3(C0[0],C0[1],C1[0]),b=MX3(C0[2],C0[3],C1[1]); a=MX3(a,C1[2],C1[3]); \
      _Pragma("unroll") for(int r=4;r<16;r+=4){a=MX3(a,C0[r],C0[r+1]);b=MX3(b,C0[r+2],C0[r+3]);a=MX3(a,C1[r],C1[r+1]);b=MX3(b,C1[r+2],C1[r+3]);} \
      float rm=__builtin_fmaxf(a,b); { auto rr=__builtin_amdgcn_permlane32_swap(__float_as_uint(rm),__float_as_uint(rm),false,false); rm=__builtin_fmaxf(__uint_as_float(rr[0]),__uint_as_float(rr[1])); } \
      resc=false; \
      if(__builtin_expect(__any(rm>(float)THRL),0)){ const float dl=__builtin_fmaxf(rm,0.f); mhat+=dl; \
        _Pragma("unroll") for(int r=0;r<16;++r){C0[r]-=dl;C1[r]-=dl;} \
        _Pragma("unroll") for(int r=0;r<16;++r)negm[r]=-mhat; asm volatile("":"+v"(negm)); \
        const float f=__builtin_amdgcn_exp2f(-dl); l_reg*=f; if(hi==0)wsf[r32]=f; resc=true; } } \
    SBAR(); \
    GAPB(o[0]=__builtin_amdgcn_mfma_f32_32x32x16_bf16(PAF(0),VFR(0),o[0],0,0,0), C0,0); \
    GAPB(o[1]=__builtin_amdgcn_mfma_f32_32x32x16_bf16(PAF(0),VFR(4),o[1],0,0,0), C0,4); \
    KRD(GL,0); GAPB(o[0]=__builtin_amdgcn_mfma_f32_32x32x16_bf16(PAF(1),VFR(1),o[0],0,0,0), C0,8); \
    KRD(GL,1); GAPB(o[1]=__builtin_amdgcn_mfma_f32_32x32x16_bf16(PAF(1),VFR(5),o[1],0,0,0), C0,12); \
    KRD(GL,2); GAPB(o[0]=__builtin_amdgcn_mfma_f32_32x32x16_bf16(PAF(2),VFR(2),o[0],0,0,0), C1,0); \
    KRD(GL,3); GAPB(o[1]=__builtin_amdgcn_mfma_f32_32x32x16_bf16(PAF(2),VFR(6),o[1],0,0,0), C1,4); \
    GAPB(o[0]=__builtin_amdgcn_mfma_f32_32x32x16_bf16(PAF(3),VFR(3),o[0],0,0,0), C1,8); \
    GAPB(o[1]=__builtin_amdgcn_mfma_f32_32x32x16_bf16(PAF(3),VFR(7),o[1],0,0,0), C1,12); \
    }while(0)
  int t=1;
  #undef CMASK
  #define CMASK(P0,P1,t) do{}while(0)
  for(;t+5<NT;t+=2){
    STEP(pB0,pB1,pA0,pA1,t,true,true,true);     WAIT_BAR(2); RESC(); ROT();
    STEP(pA0,pA1,pB0,pB1,t+1,true,true,true);   WAIT_BAR(2); RESC(); ROT();
  }
  #undef CMASK
  #define CMASK(P0,P1,t) do{}while(0)
  #define ENDW(tt) do{ if((tt)+3<NT){WAIT_BAR(2);} else if((tt)+2<NT){WAIT_BAR(1);} else {WAIT_BAR(0);} }while(0)
  for(;t+1<NT;t+=2){
    STEP(pB0,pB1,pA0,pA1,t,(t+3<NT),(t+1<NT),(t+1<NT));       ENDW(t);   RESC(); ROT();
    STEP(pA0,pA1,pB0,pB1,t+1,(t+4<NT),(t+2<NT),(t+2<NT));     ENDW(t+1); RESC(); ROT();
  }
  STEP(pB0,pB1,pA0,pA1,NT-1,false,false,false); RESC();
  { float sacc=pB0[0]+pB0[1]; _Pragma("unroll") for(int r=2;r<16;++r)sacc+=pB0[r]; _Pragma("unroll") for(int r=0;r<16;++r)sacc+=pB1[r]; l_reg+=sacc;
    pw0=(u32x4){PKW(pB0,0),PKW(pB0,2),PKW(pB0,4),PKW(pB0,6)};pw1=(u32x4){PKW(pB0,8),PKW(pB0,10),PKW(pB0,12),PKW(pB0,14)};pw2=(u32x4){PKW(pB1,0),PKW(pB1,2),PKW(pB1,4),PKW(pB1,6)};pw3=(u32x4){PKW(pB1,8),PKW(pB1,10),PKW(pB1,12),PKW(pB1,14)};
    SBAR(); pv(o,vb0+sl_cur,PAF(0),PAF(1),PAF(2),PAF(3)); }
  #undef PKW
  #undef PAF
  #undef VFR
  #undef PIN
  #undef MX3
  #undef GAPA
  #undef GAPB
  #undef EX
  #undef VRD
  #undef KRD
  #undef STEP
  #undef ENDW
  {auto rr=__builtin_amdgcn_permlane32_swap(__float_as_uint(l_reg),__float_as_uint(l_reg),false,false);l_reg=__uint_as_float(rr[0])+__uint_as_float(rr[1]);}
  if(hi==0)wsf[32+r32]=l_reg;asm volatile("s_waitcnt lgkmcnt(0)":::"memory");
  float rli[16];
  #pragma unroll
  for(int r=0;r<16;++r)rli[r]=__builtin_amdgcn_rcpf(wsf[32+crow(r,hi)]);
  bf16*Ow=O+(qrow0+wid*QBLK)*OP+h*D;
  { bf16*stg=(bf16*)(shm+LDS_OST)+wid*2048;
    #pragma unroll
    for(int r=0;r<16;++r){const int orow=crow(r,hi);
      #pragma unroll
      for(int d0=0;d0<2;++d0)stg[orow*64+d0*32+r32]=__float2bfloat16(o[d0][r]*rli[r]);}
    asm volatile("s_waitcnt lgkmcnt(0)":::"memory");
    #pragma unroll
    for(int i=0;i<4;++i){const int row=i*8+(lane>>3),ch=lane&7; const u32x4 v=*(const u32x4*)(stg+row*64+ch*8); ATTN_STORE16(Ow+(long)row*OP+ch*8,v);} }
  asm volatile("s_waitcnt lgkmcnt(0)\n\ts_barrier":::"memory");
  #undef DMA_K
  #undef DMA_V
  #undef CMASK
  #undef START
  #undef RESC
  #undef ROT
}
constexpr int ATTN_LDS_BYTES=LDS_BYTES;
#undef SBAR
#undef WAIT_BAR
}
constexpr int NWAVES = 8, NT_BLK = NWAVES * 64;
constexpr int DM = 1024, MROWS = 12288, MCTX = 8192, TLAT = 2048, TCTX = 256, PAST = 256;
constexpr int NPROJ = 2336, LDP = 2560;
constexpr int DFF = 2816;
constexpr int C_QG = 0, C_KG = 256, C_VG = 512, C_OG = 1024, C_LR = 1536, C_QA = 1568, C_KA = 2080, C_VA = 2208;
constexpr int KVLAT = TLAT + PAST;
constexpr int NCHUNK = MROWS / 64, NITEM = NCHUNK * 4;
constexpr float EPS = 1e-6f;
constexpr size_t MiB = 1u << 20;
constexpr size_t WS_MOD = 1 * MiB, WS_DECAY = 2 * MiB, WS_WIN = 3 * MiB, WS_WOUT = 8 * MiB, WS_W13 = 10 * MiB, WS_W2 = 21 * MiB;
constexpr size_t WS_KVK = 27 * MiB, WS_KVV = 31 * MiB, WS_XN = 35 * MiB, WS_MIX = 59 * MiB, WS_PROJ = 83 * MiB, WS_QB = 143 * MiB, WS_G = 83 * MiB;
constexpr size_t WS_U = 155 * MiB, WS_SPREV = 203 * MiB, WS_END = 227 * MiB;
static_assert(WS_PROJ + (size_t)MROWS * LDP * 2 <= WS_QB && WS_QB + (size_t)MROWS * 512 * 2 <= WS_U && WS_G + (size_t)MROWS * DFF * 2 <= WS_U, "ws map");
static_assert(WS_U + (size_t)NITEM * 2 * 8192 * 4 <= WS_SPREV && WS_SPREV + (size_t)NITEM * 2 * 8192 * 2 <= WS_END, "ws map 2");
constexpr int LDS_BYTES = 147456;
constexpr size_t OUT_K = (size_t)MROWS * DM, OUT_V = OUT_K + 1048576, OUT_SF = OUT_V + 1048576, OUT_SB = OUT_SF + 1048576;

#define LAS __attribute__((address_space(3)))
typedef unsigned short bf16;
typedef unsigned v4u __attribute__((ext_vector_type(4)));
typedef unsigned v2u __attribute__((ext_vector_type(2)));
typedef float f32x4 __attribute__((ext_vector_type(4)));
typedef short bf16x8 __attribute__((ext_vector_type(8)));
#define LDS_WAIT() asm volatile("s_waitcnt lgkmcnt(0)" ::: "memory")
__device__ __forceinline__ unsigned f2bf(float f) { unsigned u = __builtin_bit_cast(unsigned, f); return (u + 0x7fffu + ((u >> 16) & 1u)) >> 16; }
__device__ __forceinline__ unsigned pk2(float lo, float hi) { return f2bf(lo) | (f2bf(hi) << 16); }
__device__ __forceinline__ float bflo(unsigned u) { return __builtin_bit_cast(float, u << 16); }
__device__ __forceinline__ float bfhi(unsigned u) { return __builtin_bit_cast(float, u & 0xffff0000u); }
__device__ __forceinline__ float bf1(bf16 b) { return __builtin_bit_cast(float, (unsigned)b << 16); }
__device__ __forceinline__ float wave_sum(float v) {
#pragma unroll
    for (int o = 1; o < 64; o <<= 1) v += __shfl_xor(v, o);
    return v;
}
__device__ __forceinline__ float siluf(float x) { return x / (1.0f + __expf(-x)); }
__device__ __forceinline__ float logsigf(float x) { return fminf(x, 0.f) - log1pf(__expf(-fabsf(x))); }

struct Args { const float* in[23]; float* out; unsigned char* ws; int ph_lo, ph_hi; };

__device__ __forceinline__ void p0_transpose_item(const float* W, int K, int N, bf16* WT, int k0, int n0, int drow0, LAS float* scr, int lane) {
#pragma unroll 8
    for (int i = 0; i < 32; ++i) { const int kk = 2 * i + (lane >> 5); scr[kk * 33 + (lane & 31)] = W[(size_t)(k0 + kk) * N + n0 + (lane & 31)]; }
    LDS_WAIT(); asm volatile("" ::: "memory");
    const int c = lane & 7;
#pragma unroll
    for (int j = 0; j < 4; ++j) { const int n = (lane >> 3) + 8 * j; const LAS float* s = scr + (8 * c) * 33 + n;
        v4u o; o.x = pk2(s[0 * 33], s[1 * 33]); o.y = pk2(s[2 * 33], s[3 * 33]); o.z = pk2(s[4 * 33], s[5 * 33]); o.w = pk2(s[6 * 33], s[7 * 33]);
        *(v4u*)(WT + (size_t)(drow0 + n) * K + k0 + 8 * c) = o; }
    LDS_WAIT(); asm volatile("" ::: "memory");
}
__device__ __forceinline__ void p0_adaln(LAS unsigned char* lds, const float* c_lat, const float* c_ctx, const float* ada_w, const float* ada_b, float* MOD, int tid) {
    LAS float* ST = (LAS float*)lds; LAS float* RED = (LAS float*)(lds + 12288);
    for (int i = tid; i < 3072; i += NT_BLK) { const int cc = i >> 10, k = i & 1023; const float x = cc == 0 ? c_ctx[k] : c_lat[(cc - 1) * 1024 + k]; ST[i] = siluf(x); }
    __syncthreads();
    for (int cb = blockIdx.x; cb < 256; cb += gridDim.x) {
        const int n0 = cb * 24;
        if (tid < 384) {
            const int cg_ = tid % 6, ks = tid / 6;
            f32x4 a0 = {0.f, 0.f, 0.f, 0.f}, a1 = a0, a2 = a0;
#pragma unroll 16
            for (int kk = 0; kk < 16; ++kk) { const int k = ks * 16 + kk; const f32x4 w = *(const f32x4*)(ada_w + (size_t)k * 6144 + n0 + cg_ * 4);
                a0 += w * ST[k]; a1 += w * ST[1024 + k]; a2 += w * ST[2048 + k]; }
            LAS float* r = RED + (ks * 6 + cg_) * 12;
#pragma unroll
            for (int e = 0; e < 4; ++e) { r[e] = a0[e]; r[4 + e] = a1[e]; r[8 + e] = a2[e]; }
        }
        __syncthreads();
        if (tid < 72) { const int cc = tid / 24, col = tid % 24, cg_ = col >> 2, e = col & 3; float s = 0.f;
            for (int ks = 0; ks < 64; ++ks) s += RED[(ks * 6 + cg_) * 12 + cc * 4 + e];
            MOD[cc * 6144 + n0 + col] = s + ada_b[n0 + col]; }
        __syncthreads();
    }
}
__device__ __forceinline__ void norm_mod_row(const float* xrow, const float* gain, const float* shift, const float* scale, bf16* orow, int lane) {
    const f32x4* xr = (const f32x4*)xrow + lane; f32x4 v[4]; float s = 0.f;
#pragma unroll
    for (int j = 0; j < 4; ++j) { v[j] = xr[64 * j]; s += (v[j].x * v[j].x + v[j].y * v[j].y) + (v[j].z * v[j].z + v[j].w * v[j].w); }
    const float rstd = 1.0f / sqrtf(wave_sum(s) * (1.f / DM) + EPS);
    v2u* o8 = (v2u*)orow + lane;
#pragma unroll
    for (int j = 0; j < 4; ++j) { const f32x4 g = ((const f32x4*)gain)[lane + 64 * j], sh = ((const f32x4*)shift)[lane + 64 * j], sc = ((const f32x4*)scale)[lane + 64 * j];
        const f32x4 h = (v[j] * rstd * g) * (sc + 1.0f) + sh; v2u w; w.x = pk2(h.x, h.y); w.y = pk2(h.z, h.w); o8[64 * j] = w; }
}
__device__ __forceinline__ void final_norm_row(float* xrow, const float* gain, int lane) {
    f32x4* xr = (f32x4*)xrow + lane; f32x4 v[4]; float s = 0.f;
#pragma unroll
    for (int j = 0; j < 4; ++j) { v[j] = xr[64 * j]; s += (v[j].x * v[j].x + v[j].y * v[j].y) + (v[j].z * v[j].z + v[j].w * v[j].w); }
    const float rstd = 1.0f / sqrtf(wave_sum(s) * (1.f / DM) + EPS);
#pragma unroll
    for (int j = 0; j < 4; ++j) xr[64 * j] = v[j] * rstd * ((const f32x4*)gain)[lane + 64 * j];
}
__device__ __forceinline__ void prep_row(int r, const bf16* PROJ, const float* qg, const float* kg, bf16* QB, bf16* KVK, bf16* KVV, float* out, int lane) {
    const bool lat = r >= MCTX; const bf16* prow = PROJ + (size_t)r * LDP;
    float cs = 1.f, sn = 0.f; size_t kvrow = (size_t)r;
    if (lat) { const int rr = r - MCTX, b = rr >> 11, t = rr & 2047; kvrow = (size_t)MCTX + (size_t)b * KVLAT + t;
        const int a = lane >> 5, f = lane & 15; const float pos = (float)(a ? (t & 63) : (t >> 6));
        const float inv = exp2f(-(float)f * (13.287712379549449f / 16.0f));
        sincosf(pos * inv, &sn, &cs); }
    const bool p1 = (lane >> 4) & 1;
    const float gq = qg[lane], gk = kg[lane];
    constexpr float C2 = 0.125f * 1.4426950408889634f;
#pragma unroll
    for (int hh = 0; hh < 8; ++hh) { const float x = bf1(prow[C_QA + hh * 64 + lane]); const float ss = wave_sum(x * x);
        float y = x * (1.0f / sqrtf(ss * (1.f / 64.f) + EPS)) * gq;
        if (lat) { const float o = __shfl_xor(y, 16); y = p1 ? (o * sn + y * cs) : (y * cs - o * sn); }
        QB[(size_t)r * 512 + hh * 64 + lane] = (bf16)f2bf(y * C2); }
#pragma unroll
    for (int kh = 0; kh < 2; ++kh) { const float x = bf1(prow[C_KA + kh * 64 + lane]); const float ss = wave_sum(x * x);
        float y = x * (1.0f / sqrtf(ss * (1.f / 64.f) + EPS)) * gk;
        if (lat) { const float o = __shfl_xor(y, 16); y = p1 ? (o * sn + y * cs) : (y * cs - o * sn); }
        else out[OUT_K + (size_t)r * 128 + kh * 64 + lane] = y;
        KVK[kvrow * 128 + kh * 64 + lane] = (bf16)f2bf(y); }
    { const unsigned raw = *(const unsigned*)(prow + C_VA + 2 * lane);
      *(unsigned*)(KVV + kvrow * 128 + 2 * lane) = raw;
      if (!lat) { float2 o; o.x = bflo(raw); o.y = bfhi(raw); *(float2*)(out + OUT_V + (size_t)r * 128 + 2 * lane) = o; } }
}
#define XB_TMO      128
#define XB_XCNT(j)  (256  + 64 * (j))
#define XB_XSUB(j)  (1280 + 64 * (j))
#define XB_XGEN(j)  (2304 + 64 * (j))
#define XB_TOP      3328
#define XB_TOPGEN   3392
#define XCD_BAR_WORDS 3456
#define XB_SPIN_CAP (1u << 18)

__device__ __forceinline__ unsigned xb_ld(unsigned* p)              { return __hip_atomic_load(p, __ATOMIC_RELAXED, __HIP_MEMORY_SCOPE_AGENT); }
__device__ __forceinline__ unsigned xb_add(unsigned* p, unsigned v) { return __hip_atomic_fetch_add(p, v, __ATOMIC_RELAXED, __HIP_MEMORY_SCOPE_AGENT); }
__device__ __forceinline__ unsigned xb_xcc_id() { return (unsigned)__builtin_amdgcn_s_getreg((3 << 11) | 20) & 0xFu; }
#define XB_SPIN(cond, bar) do { unsigned _sp = 0; while (cond) { __builtin_amdgcn_s_sleep(1); \
    if ((++_sp & 255u) == 0u) { if (xb_ld(&(bar)[XB_TMO])) break; if (_sp > XB_SPIN_CAP) { atomicAdd(&(bar)[XB_TMO], 1u); break; } } } } while (0)

struct XcdBarrier {
    unsigned* bar; unsigned x;
    volatile LAS unsigned* st;
};

__device__ __forceinline__ XcdBarrier xcd_barrier_post(unsigned* bar, volatile LAS unsigned* st) {
    XcdBarrier b; b.bar = bar; b.x = xb_xcc_id(); b.st = st;
    if (threadIdx.x == 0) (void)xb_add(&bar[XB_XCNT(b.x)], 1u);
    return b;
}
__device__ __forceinline__ void xcd_barrier_complete(unsigned* bar, unsigned x, unsigned& nloc, unsigned& nx) {
    const unsigned G = gridDim.x * gridDim.y * gridDim.z;
    unsigned sum, cnt, mine, sp = 0u;
    for (;;) {
        sum = 0u; cnt = 0u; mine = 0u;
#pragma unroll
        for (unsigned j = 0; j < 16; ++j) { const unsigned c = xb_ld(&bar[XB_XCNT(j)]); sum += c; cnt += (c > 0u) ? 1u : 0u; mine = (j == x) ? c : mine; }
        if (sum == G) break;
        __builtin_amdgcn_s_sleep(1);
        if ((++sp & 255u) == 0u) { if (xb_ld(&bar[XB_TMO])) break; if (sp > XB_SPIN_CAP) { atomicAdd(&bar[XB_TMO], 1u); break; } }
    }
    nloc = mine > 0u ? mine : 1u; nx = cnt > 0u ? cnt : 1u;
}

__device__ __forceinline__ void xcd_barrier(const XcdBarrier& b) {
    asm volatile("s_waitcnt vmcnt(0)" ::: "memory");
    __syncthreads();
    if (threadIdx.x == 0) {
        unsigned* bar = b.bar;
        __builtin_amdgcn_s_waitcnt(0);
        unsigned nloc = b.st[0], nx = b.st[1];
        if (nloc == 0u) { xcd_barrier_complete(bar, b.x, nloc, nx); b.st[0] = nloc; b.st[1] = nx; }
        const unsigned old = xb_add(&bar[XB_XSUB(b.x)], 1u);
        const unsigned gen = old / nloc;
        if (old + 1u == (gen + 1u) * nloc) {
            __builtin_amdgcn_fence(__ATOMIC_RELEASE, "agent");
            asm volatile("s_waitcnt vmcnt(0)" ::: "memory");
            const unsigned og = xb_add(&bar[XB_TOP], 1u);
            const unsigned tg = og / nx;
            if (og + 1u == (tg + 1u) * nx) xb_add(&bar[XB_TOPGEN], 1u);
            else XB_SPIN(xb_ld(&bar[XB_TOPGEN]) == tg, bar);
            __builtin_amdgcn_fence(__ATOMIC_ACQUIRE, "agent");
            xb_add(&bar[XB_XGEN(b.x)], 1u);
            asm volatile("s_waitcnt vmcnt(0)" ::: "memory");
        } else {
            XB_SPIN(xb_ld(&bar[XB_XGEN(b.x)]) == gen, bar);
            __builtin_amdgcn_fence(__ATOMIC_ACQUIRE, "agent");
            asm volatile("s_waitcnt vmcnt(0)" ::: "memory");
        }
    }
    __syncthreads();
}

constexpr int GL_LR = 0;
constexpr int GL_GB = 8192;
constexpr int GL_O = 0;
constexpr int GL_A = 41472;
constexpr int GL_BT = GL_A + 64 * 400;
constexpr int GL_KT = GL_BT + 128 * 400;
constexpr int GL_END = GL_KT + 2 * 64 * 144;
static_assert(GL_END <= LDS_BYTES - 1024 && 64 * 132 * 4 <= GL_A, "GLA LDS map");
constexpr int GA_S = 200, GK_S = 72;

__device__ __forceinline__ void gla_gates(LAS unsigned char* lds, const bf16* PROJ, const float* w_gk2, const float* b_gk2, int c, int h, int tid) {
    LAS float* LR = (LAS float*)(lds + GL_LR); LAS float* GB = (LAS float*)(lds + GL_GB);
    { const int i = tid >> 3, c4 = (tid & 7) * 4; const v2u raw = *(const v2u*)(PROJ + (size_t)(64 * c + i) * LDP + C_LR + c4);
      LR[i * 32 + c4] = bflo(raw.x); LR[i * 32 + c4 + 1] = bfhi(raw.x); LR[i * 32 + c4 + 2] = bflo(raw.y); LR[i * 32 + c4 + 3] = bfhi(raw.y); }
    __syncthreads();
    { const int d = tid & 63, ig = tid >> 6; float w0[16], w1[16];
#pragma unroll
      for (int l = 0; l < 16; ++l) { w0[l] = w_gk2[l * 256 + h * 64 + d]; w1[l] = w_gk2[(16 + l) * 256 + h * 64 + d]; }
      const float b0 = b_gk2[h * 64 + d], b1 = b_gk2[256 + h * 64 + d];
#pragma unroll
      for (int r = 0; r < 8; ++r) { const int i = ig * 8 + r; float a0 = b0, a1 = b1;
#pragma unroll
          for (int l = 0; l < 16; ++l) { a0 += LR[i * 32 + l] * w0[l]; a1 += LR[i * 32 + 16 + l] * w1[l]; }
          GB[i * 65 + d] = logsigf(a0) * (1.f / 16.f); GB[(64 + i) * 65 + d] = logsigf(a1) * (1.f / 16.f); } }
    __syncthreads();
    if (tid < 128) { const int d = tid & 63; float s = 0.f;
        if (tid < 64) { for (int i = 0; i < 64; ++i) { s += GB[i * 65 + d]; GB[i * 65 + d] = s; } }
        else { for (int i = 63; i >= 0; --i) { s += GB[(64 + i) * 65 + d]; GB[(64 + i) * 65 + d] = s; } } }
    __syncthreads();
}
__device__ __forceinline__ void gla_load_vt(LAS bf16* dst, int stride, const bf16* PROJ, int c, int h, int tid) {
    const int j = tid & 63, vg = tid >> 6;
#pragma unroll
    for (int p = 0; p < 2; ++p) { const int v0 = (vg + 8 * p) * 8; const v4u raw = *(const v4u*)(PROJ + (size_t)(64 * c + j) * LDP + C_VG + h * 128 + v0);
#pragma unroll
        for (int e = 0; e < 4; ++e) { dst[(v0 + 2 * e) * stride + j] = (bf16)(raw[e] & 0xffffu); dst[(v0 + 2 * e + 1) * stride + j] = (bf16)(raw[e] >> 16); } }
}
__device__ __forceinline__ void gla_u_item(LAS unsigned char* lds, const bf16* PROJ, const float* w_gk2, const float* b_gk2, float* U, float* DECAY, int item, int tid) {
    const int c = item >> 2, h = item & 3, lane = tid & 63, w = tid >> 6;
    LAS float* GB = (LAS float*)(lds + GL_GB); LAS bf16* VT = (LAS bf16*)(lds + GL_A); LAS bf16* KE = (LAS bf16*)(lds + GL_KT);
    gla_gates(lds, PROJ, w_gk2, b_gk2, c, h, tid);
    gla_load_vt(VT, GK_S, PROJ, c, h, tid);
    { const int j = tid & 63, dg = tid >> 6; const v4u raw = *(const v4u*)(PROJ + (size_t)(64 * c + j) * LDP + C_KG + h * 64 + dg * 8);
#pragma unroll
      for (int e = 0; e < 8; ++e) { const int d = dg * 8 + e; const float k = (e & 1) ? bfhi(raw[e >> 1]) : bflo(raw[e >> 1]);
          const float ef = __expf(GB[63 * 65 + d] - GB[j * 65 + d]), eb = __expf(GB[64 * 65 + d] - GB[(64 + j) * 65 + d]);
          KE[d * GK_S + j] = (bf16)f2bf(k * ef); KE[(64 + d) * GK_S + j] = (bf16)f2bf(k * eb); } }
    if (tid < 128) { const int d = tid & 63, dir = tid >> 6; DECAY[((size_t)item * 2 + dir) * 64 + d] = __expf(dir ? GB[64 * 65 + d] : GB[63 * 65 + d]); }
    __syncthreads();
    f32x4 acc[2][4];
#pragma unroll
    for (int dir = 0; dir < 2; ++dir)
#pragma unroll
        for (int nt = 0; nt < 4; ++nt) acc[dir][nt] = (f32x4){0.f, 0.f, 0.f, 0.f};
#pragma unroll
    for (int ks = 0; ks < 2; ++ks) { const bf16x8 a = *(const LAS bf16x8*)(VT + (16 * w + (lane & 15)) * GK_S + ks * 32 + (lane >> 4) * 8);
#pragma unroll
        for (int dir = 0; dir < 2; ++dir)
#pragma unroll
            for (int nt = 0; nt < 4; ++nt) { const bf16x8 b = *(const LAS bf16x8*)(KE + (dir * 64 + 16 * nt + (lane & 15)) * GK_S + ks * 32 + (lane >> 4) * 8);
                acc[dir][nt] = __builtin_amdgcn_mfma_f32_16x16x32_bf16(a, b, acc[dir][nt], 0, 0, 0); } }
#pragma unroll
    for (int dir = 0; dir < 2; ++dir) { float* up = U + ((size_t)item * 2 + dir) * 8192;
#pragma unroll
        for (int nt = 0; nt < 4; ++nt)
#pragma unroll
            for (int r = 0; r < 4; ++r) up[(16 * w + (lane >> 4) * 4 + r) * 64 + 16 * nt + (lane & 15)] = acc[dir][nt][r]; }
    __syncthreads();
}
template <int NJ, int N, int GRP, bool LAT>
__device__ __forceinline__ void gla_scan_job(int job, const float* __restrict__ U, const float* __restrict__ DECAY, bf16* __restrict__ SPREV, const float* __restrict__ sf_in, const float* __restrict__ sb_in, float* __restrict__ out, int tid) {
    constexpr int QN = 16 / NJ;
    const int chain = job / QN, q = job % QN, b = chain >> 3, h = (chain >> 1) & 3, dir = chain & 1, cbase = LAT ? 128 + b * 32 : b * 4;
    const int e0 = NJ * q * 512 + tid, d = e0 & 63;
    float s[NJ];
#pragma unroll
    for (int jj = 0; jj < NJ; ++jj) { const int v = (e0 + jj * 512) >> 6; s[jj] = LAT ? (dir ? sb_in : sf_in)[((size_t)(b * 4 + h) * 64 + d) * 128 + v] : 0.f; }
    for (int n0 = 0; n0 < N; n0 += GRP) {
        float u[GRP][NJ], dc[GRP];
#pragma unroll
        for (int k = 0; k < GRP; ++k) { const int n = dir ? N - 1 - (n0 + k) : n0 + k; const size_t idx = ((size_t)(cbase + n) * 4 + h) * 2 + dir; dc[k] = DECAY[idx * 64 + d];
#pragma unroll
            for (int jj = 0; jj < NJ; ++jj) u[k][jj] = U[idx * 8192 + e0 + jj * 512]; }
#pragma unroll
        for (int k = 0; k < GRP; ++k) { const int n = dir ? N - 1 - (n0 + k) : n0 + k; const size_t idx = ((size_t)(cbase + n) * 4 + h) * 2 + dir;
#pragma unroll
            for (int jj = 0; jj < NJ; ++jj) { SPREV[idx * 8192 + e0 + jj * 512] = (bf16)f2bf(s[jj]); s[jj] = dc[k] * s[jj] + u[k][jj]; } }
    }
    if (!LAT) {
#pragma unroll
        for (int jj = 0; jj < NJ; ++jj) { const int v = (e0 + jj * 512) >> 6; out[(dir ? OUT_SB : OUT_SF) + ((size_t)(b * 4 + h) * 64 + d) * 128 + v] = s[jj]; } }
}
__device__ __forceinline__ void gla_scan(const float* __restrict__ U, const float* __restrict__ DECAY, bf16* __restrict__ SPREV, const float* __restrict__ sf_in, const float* __restrict__ sb_in, float* __restrict__ out, int tid, int li, int nl) {
    for (int job = li; job < 16 * 8; job += nl) gla_scan_job<2, 32, 8, true>(job, U, DECAY, SPREV, sf_in, sb_in, out, tid);
    for (int job = li; job < 256 * 4; job += nl) gla_scan_job<4, 4, 4, false>(job, U, DECAY, SPREV, sf_in, sb_in, out, tid);
}
__device__ __forceinline__ void gla_o_item(LAS unsigned char* lds, const bf16* PROJ, const float* w_gk2, const float* b_gk2, const bf16* SPREV, const float* gla_g, bf16* MIX, int item, int tid) {
    const int c = item >> 2, h = item & 3, lane = tid & 63, w = tid >> 6;
    LAS float* GB = (LAS float*)(lds + GL_GB); LAS bf16* A = (LAS bf16*)(lds + GL_A); LAS bf16* BT = (LAS bf16*)(lds + GL_BT); LAS bf16* KT = (LAS bf16*)(lds + GL_KT);
    LAS float* O = (LAS float*)(lds + GL_O);
    gla_gates(lds, PROJ, w_gk2, b_gk2, c, h, tid);
    { const int i = tid >> 3, dg = tid & 7; const bf16* prow = PROJ + (size_t)(64 * c + i) * LDP + h * 64 + dg * 8;
      const v4u qr = *(const v4u*)(prow + C_QG), kr = *(const v4u*)(prow + C_KG);
      v4u qf, qb, kf, kb;
#pragma unroll
      for (int e2 = 0; e2 < 4; ++e2) { const int d = dg * 8 + 2 * e2;
          const float bf0 = GB[i * 65 + d], bf1_ = GB[i * 65 + d + 1], bb0 = GB[(64 + i) * 65 + d], bb1 = GB[(64 + i) * 65 + d + 1];
          const float q0 = bflo(qr[e2]) * 0.125f, q1 = bfhi(qr[e2]) * 0.125f, k0 = bflo(kr[e2]), k1 = bfhi(kr[e2]);
          qf[e2] = pk2(q0 * __expf(bf0), q1 * __expf(bf1_)); qb[e2] = pk2(q0 * __expf(bb0), q1 * __expf(bb1));
          kf[e2] = pk2(k0 * __expf(-bf0), k1 * __expf(-bf1_)); kb[e2] = pk2(k0 * __expf(-bb0), k1 * __expf(-bb1)); }
      *(LAS v4u*)(A + i * GA_S + 64 + dg * 8) = qf; *(LAS v4u*)(A + i * GA_S + 128 + dg * 8) = qb;
      *(LAS v4u*)(KT + i * GK_S + dg * 8) = kf; *(LAS v4u*)(KT + (64 + i) * GK_S + dg * 8) = kb; }
    gla_load_vt(BT, GA_S, PROJ, c, h, tid);
    { const int v = tid >> 2, part = tid & 3;
#pragma unroll
      for (int dir = 0; dir < 2; ++dir) { const bf16* sp = SPREV + ((size_t)item * 2 + dir) * 8192 + v * 64 + part * 16;
          const v4u s0 = *(const v4u*)sp, s1 = *(const v4u*)(sp + 8);
          *(LAS v4u*)(BT + v * GA_S + 64 + dir * 64 + part * 16) = s0; *(LAS v4u*)(BT + v * GA_S + 64 + dir * 64 + part * 16 + 8) = s1; } }
    __syncthreads();
    { const int rt = w & 3, jh = w >> 2; f32x4 sf[2], sb[2];
#pragma unroll
      for (int nt = 0; nt < 2; ++nt) { sf[nt] = (f32x4){0.f, 0.f, 0.f, 0.f}; sb[nt] = sf[nt]; }
#pragma unroll
      for (int ks = 0; ks < 2; ++ks) {
          const bf16x8 af = *(const LAS bf16x8*)(A + (16 * rt + (lane & 15)) * GA_S + 64 + ks * 32 + (lane >> 4) * 8);
          const bf16x8 ab = *(const LAS bf16x8*)(A + (16 * rt + (lane & 15)) * GA_S + 128 + ks * 32 + (lane >> 4) * 8);
#pragma unroll
          for (int nt = 0; nt < 2; ++nt) { const int jr = jh * 32 + 16 * nt + (lane & 15);
              const bf16x8 bfv = *(const LAS bf16x8*)(KT + jr * GK_S + ks * 32 + (lane >> 4) * 8);
              const bf16x8 bbv = *(const LAS bf16x8*)(KT + (64 + jr) * GK_S + ks * 32 + (lane >> 4) * 8);
              sf[nt] = __builtin_amdgcn_mfma_f32_16x16x32_bf16(af, bfv, sf[nt], 0, 0, 0);
              sb[nt] = __builtin_amdgcn_mfma_f32_16x16x32_bf16(ab, bbv, sb[nt], 0, 0, 0); } }
#pragma unroll
      for (int nt = 0; nt < 2; ++nt)
#pragma unroll
          for (int r = 0; r < 4; ++r) { const int i = 16 * rt + (lane >> 4) * 4 + r, j = jh * 32 + 16 * nt + (lane & 15);
              const float p = (j <= i ? sf[nt][r] : 0.f) + (j >= i ? sb[nt][r] : 0.f); A[i * GA_S + j] = (bf16)f2bf(p); } }
    __syncthreads();
    { const int rt = w & 3, ch = w >> 2; f32x4 acc[4];
#pragma unroll
      for (int nt = 0; nt < 4; ++nt) acc[nt] = (f32x4){0.f, 0.f, 0.f, 0.f};
#pragma unroll
      for (int ks = 0; ks < 6; ++ks) { const bf16x8 a = *(const LAS bf16x8*)(A + (16 * rt + (lane & 15)) * GA_S + ks * 32 + (lane >> 4) * 8);
#pragma unroll
          for (int nt = 0; nt < 4; ++nt) { const bf16x8 b = *(const LAS bf16x8*)(BT + (ch * 64 + 16 * nt + (lane & 15)) * GA_S + ks * 32 + (lane >> 4) * 8);
              acc[nt] = __builtin_amdgcn_mfma_f32_16x16x32_bf16(a, b, acc[nt], 0, 0, 0); } }
#pragma unroll
      for (int nt = 0; nt < 4; ++nt)
#pragma unroll
          for (int r = 0; r < 4; ++r) O[(16 * rt + (lane >> 4) * 4 + r) * 132 + ch * 64 + 16 * nt + (lane & 15)] = acc[nt][r]; }
    __syncthreads();
    { const int i = tid >> 3, part = tid & 7; float o[16]; float ss = 0.f;
#pragma unroll
      for (int e = 0; e < 16; ++e) { o[e] = O[i * 132 + part * 16 + e]; ss += o[e] * o[e]; }
      ss += __shfl_xor(ss, 1); ss += __shfl_xor(ss, 2); ss += __shfl_xor(ss, 4);
      const float rstd = 1.0f / sqrtf(ss * (1.f / 128.f) + EPS);
      const bf16* ogp = PROJ + (size_t)(64 * c + i) * LDP + C_OG + h * 128 + part * 16; const v4u g0 = *(const v4u*)ogp, g1 = *(const v4u*)(ogp + 8);
      v4u w0, w1;
#pragma unroll
      for (int e2 = 0; e2 < 4; ++e2) {
          const float ga = bflo(g0[e2]), gb = bfhi(g0[e2]), gc = bflo(g1[e2]), gd = bfhi(g1[e2]);
          w0[e2] = pk2(o[2 * e2] * rstd * gla_g[part * 16 + 2 * e2] * siluf(ga), o[2 * e2 + 1] * rstd * gla_g[part * 16 + 2 * e2 + 1] * siluf(gb));
          w1[e2] = pk2(o[8 + 2 * e2] * rstd * gla_g[part * 16 + 8 + 2 * e2] * siluf(gc), o[8 + 2 * e2 + 1] * rstd * gla_g[part * 16 + 8 + 2 * e2 + 1] * siluf(gd)); }
      bf16* mp = MIX + (size_t)(64 * c + i) * 1024 + h * 128 + part * 16; *(v4u*)mp = w0; *(v4u*)(mp + 8) = w1; }
    __syncthreads();
}
#ifndef MK_N_LAUNCHES
#define MK_N_LAUNCHES 1
#endif
constexpr int NPHASE = 11;
__global__ void __launch_bounds__(NT_BLK, 2) fwd_kernel(Args args) {
    extern __shared__ __attribute__((aligned(16))) unsigned char lds_raw[];
    LAS unsigned char* lds = (LAS unsigned char*)lds_raw;
    const int tid = threadIdx.x, lane = tid & 63, wave = __builtin_amdgcn_readfirstlane(tid >> 6);
    const int G = gridDim.x, gw = blockIdx.x * NWAVES + wave, NGW = G * NWAVES;
    cg::grid_group grid = cg::this_grid();
    unsigned char* ws = args.ws; float* out = args.out;
    const float* x_prompt = args.in[0]; const float* x_sample = args.in[1];
    float* MOD = (float*)(ws + WS_MOD); float* DECAY = (float*)(ws + WS_DECAY);
    bf16* WIN_T = (bf16*)(ws + WS_WIN); bf16* WOUT_T = (bf16*)(ws + WS_WOUT); bf16* W13_T = (bf16*)(ws + WS_W13); bf16* W2_T = (bf16*)(ws + WS_W2);
    bf16* KVK = (bf16*)(ws + WS_KVK); bf16* KVV = (bf16*)(ws + WS_KVV); bf16* XN = (bf16*)(ws + WS_XN); bf16* MIX = (bf16*)(ws + WS_MIX);
    bf16* PROJ = (bf16*)(ws + WS_PROJ); bf16* QB = (bf16*)(ws + WS_QB); bf16* GBUF = (bf16*)(ws + WS_G);
    float* U = (float*)(ws + WS_U); bf16* SPREV = (bf16*)(ws + WS_SPREV);
    const int lo = args.ph_lo, hi = args.ph_hi;
    volatile LAS unsigned* bst = (volatile LAS unsigned*)(lds + LDS_BYTES - 64);
    if (tid < 16) bst[tid] = 0u;
    __syncthreads();
    XcdBarrier bar = xcd_barrier_post((unsigned*)ws, bst);
#define IN(k) (lo <= (k) && (k) < hi)
#define SEAM(k) do { if (IN(k) && IN((k) + 1)) { if ((k) == 0) grid.sync(); else xcd_barrier(bar); } } while (0)

    if (IN(0)) {
        p0_adaln(lds, args.in[6], args.in[7], args.in[8], args.in[9], MOD, tid);
        LAS float* scr = (LAS float*)(lds + wave * 16384);
        constexpr int I_IN = 16 * 73, I_OUT = 16 * 32, NITEMS = I_IN + I_OUT;
        for (int it = gw; it < NITEMS; it += NGW) {
            int r = it;
            if (r < I_IN) { const int kb = r / 73, nb = r % 73; p0_transpose_item(args.in[12], 1024, NPROJ, WIN_T, 64 * kb, 32 * nb, 32 * nb, scr, lane); continue; } r -= I_IN;
            { const int kb = r / 32, nb = r % 32; p0_transpose_item(args.in[18], 1024, 1024, WOUT_T, 64 * kb, 32 * nb, 32 * nb, scr, lane); }
        }
        for (int i = gw * 64 + lane; i < (LDP - NPROJ) * 1024 / 8; i += NGW * 64) ((v4u*)(WIN_T + (size_t)NPROJ * 1024))[i] = (v4u){0u, 0u, 0u, 0u};
        for (int i = gw * 64 + lane; i < 2 * PAST * 128 / 2; i += NGW * 64) { const int b = i / (PAST * 64), rem = i % (PAST * 64);
            const float2 k = ((const float2*)args.in[2])[i], v = ((const float2*)args.in[3])[i];
            const size_t o = ((size_t)MCTX + (size_t)b * KVLAT + TLAT) * 128 + 2 * rem;
            *(unsigned*)(KVK + o) = pk2(k.x, k.y); *(unsigned*)(KVV + o) = pk2(v.x, v.y); }
    }
    SEAM(0);
    if (IN(1)) {
        for (int m = gw; m < MROWS; m += NGW) { const bool lat = m >= MCTX; const float* xr = lat ? x_sample + (size_t)(m - MCTX) * DM : x_prompt + (size_t)m * DM;
            const float* md = MOD + (lat ? 1 + ((m - MCTX) >> 11) : 0) * 6144; norm_mod_row(xr, args.in[10], md, md + 1024, XN + (size_t)m * DM, lane); }
    }
    SEAM(1);
    if (IN(2)) {
        pg8::Gemm g{XN, WIN_T, MROWS, LDP, 1024}; pg8::StaticOrder S; S.init(MROWS, LDP, G, (int)blockIdx.x);
        pg8::EpiStore E{PROJ, LDP};
        pg8::gemm_phase<pg8::EpiStore, pg8::StaticOrder, true, true>(lds, g, S, E);
    }
    SEAM(2);
    if (IN(3)) {
        for (int m = gw; m < MROWS; m += NGW) prep_row(m, PROJ, args.in[16], args.in[17], QB, KVK, KVV, out, lane);
        for (int it = blockIdx.x; it < NITEM; it += G) gla_u_item(lds, PROJ, args.in[13], args.in[14], U, DECAY, it, tid);
    }
    SEAM(3);
    if (IN(4)) {
        const bool split = G > 128; const int nl = split ? G - 128 : G, li = split ? (int)blockIdx.x - 128 : (int)blockIdx.x;
        if (!split || blockIdx.x < 128)
            for (int u = blockIdx.x; u < 128; u += (split ? 128 : G)) { const int b = u >> 6, h = (u >> 3) & 7, qb = u & 7;
                attn_body::attn_unit<8>((long)MCTX + b * TLAT + qb * 256, h, (long)MCTX + b * KVLAT, KVLAT / 64, (const attn_body::bf16*)QB, (const attn_body::bf16*)KVK, (const attn_body::bf16*)KVV, (attn_body::bf16*)(MIX + 512), (char*)lds_raw); }
        if (li >= 0) {
            gla_scan(U, DECAY, SPREV, args.in[4], args.in[5], out, tid, li, nl);
            for (int cu = li; cu < 256; cu += nl) { const int b = cu >> 3, h = cu & 7;
                attn_body::attn_unit<8>((long)b * TCTX, h, (long)b * TCTX, TCTX / 64, (const attn_body::bf16*)QB, (const attn_body::bf16*)KVK, (const attn_body::bf16*)KVV, (attn_body::bf16*)(MIX + 512), (char*)lds_raw); }
        }
    }
    SEAM(4);
    if (IN(5)) {
        for (int it = blockIdx.x; it < NITEM; it += G) gla_o_item(lds, PROJ, args.in[13], args.in[14], SPREV, args.in[15], MIX, it, tid);
    }
    SEAM(5);
    if (IN(6)) {
        pg8::Gemm g{MIX, WOUT_T, MROWS, 1024, 1024}; pg8::StaticOrder S; S.init(MROWS, 1024, G, (int)blockIdx.x);
        pg8::EpiResGate E{x_prompt, x_sample, out, MOD + 2 * 1024};
        pg8::gemm_phase<pg8::EpiResGate, pg8::StaticOrder, true, true>(lds, g, S, E);
        constexpr int NU = (MROWS / 256) * (1024 / 256);
        const int nidle = G > NU ? G - NU : G, ii = G > NU ? (int)blockIdx.x - NU : (int)blockIdx.x;
        if (ii >= 0) {
            LAS float* scr = (LAS float*)(lds + wave * 16384);
            constexpr int I_1 = 16 * 88, I_2 = 44 * 32, NITEMS = 2 * I_1 + I_2;
            for (int it = ii * NWAVES + wave; it < NITEMS; it += nidle * NWAVES) {
                int r = it;
                if (r < 2 * I_1) { const int sel = r >= I_1; if (sel) r -= I_1; const int kb = r / 88, nb = r % 88, n0 = 32 * nb;
                    p0_transpose_item(args.in[sel ? 20 : 19], 1024, DFF, W13_T, 64 * kb, n0, (n0 >> 7) * 256 + sel * 128 + (n0 & 127), scr, lane); continue; } r -= 2 * I_1;
                { const int kb = r / 32, nb = r % 32; p0_transpose_item(args.in[21], DFF, 1024, W2_T, 64 * kb, 32 * nb, 32 * nb, scr, lane); }
            }
        }
    }
    SEAM(6);
    if (IN(7)) {
        for (int m = gw; m < MROWS; m += NGW) { const bool lat = m >= MCTX;
            const float* md = MOD + (lat ? 1 + ((m - MCTX) >> 11) : 0) * 6144; norm_mod_row(out + (size_t)m * DM, args.in[11], md + 3 * 1024, md + 4 * 1024, XN + (size_t)m * DM, lane); }
    }
    SEAM(7);
    if (IN(8)) {
        pg8::Gemm g{XN, W13_T, MROWS, 2 * DFF, 1024}; pg8::StaticOrder S; S.init(MROWS, 2 * DFF, G, (int)blockIdx.x);
        pg8::EpiSwiglu E{GBUF, DFF};
        pg8::gemm_phase<pg8::EpiSwiglu, pg8::StaticOrder, true, true>(lds, g, S, E);
    }
    SEAM(8);
    if (IN(9)) {
        pg8::Gemm g{GBUF, W2_T, MROWS, 1024, DFF}; pg8::StaticOrder S; S.init(MROWS, 1024, G, (int)blockIdx.x);
        pg8::EpiResGate E{out, out + (size_t)MCTX * DM, out, MOD + 5 * 1024};
        pg8::gemm_phase<pg8::EpiResGate, pg8::StaticOrder, true, true>(lds, g, S, E);
    }
    SEAM(9);
    if (IN(10)) {
        for (int m = gw; m < MROWS; m += NGW) final_norm_row(out + (size_t)m * DM, args.in[22], lane);
    }
#undef IN
#undef SEAM
}

extern "C" void kernel_launch(void* const* d_in, const int* in_sizes, int n_in, void* d_out, int out_size, void* d_ws, size_t ws_size, hipStream_t stream) {
    static int grid = 0;
    if (grid == 0) {
        if (n_in != 23 || ws_size < WS_END) { fprintf(stderr, "kernel_launch: unexpected inputs (n_in %d, ws %zu)\n", n_in, ws_size); grid = -1; return; }
        int dev = 0, cus = 0, per_cu = 0;
        if (hipGetDevice(&dev) != hipSuccess || hipDeviceGetAttribute(&cus, hipDeviceAttributeMultiprocessorCount, dev) != hipSuccess) { grid = -1; return; }
        if (hipFuncSetAttribute((const void*)fwd_kernel, hipFuncAttributeMaxDynamicSharedMemorySize, LDS_BYTES) != hipSuccess) { fprintf(stderr, "kernel_launch: hipFuncSetAttribute failed\n"); grid = -1; return; }
        if (hipOccupancyMaxActiveBlocksPerMultiprocessor(&per_cu, (const void*)fwd_kernel, NT_BLK, LDS_BYTES) != hipSuccess || per_cu < 1) { fprintf(stderr, "kernel_launch: occupancy query says %d\n", per_cu); per_cu = 1; }
        (void)hipGetLastError();
        grid = cus;
    }
    if (grid < 0) return;
    if (hipMemsetAsync(d_ws, 0, 65536, stream) != hipSuccess) { fprintf(stderr, "kernel_launch: memset failed\n"); return; }
    Args a{};
    for (int i = 0; i < 23; ++i) a.in[i] = (const float*)d_in[i];
    a.out = (float*)d_out; a.ws = (unsigned char*)d_ws;
    if (MK_N_LAUNCHES == 1) {
        a.ph_lo = 0; a.ph_hi = NPHASE;
        void* kargs[] = {&a};
        hipError_t e = hipLaunchCooperativeKernel((const void*)fwd_kernel, dim3(grid), dim3(NT_BLK), kargs, LDS_BYTES, stream);
        if (e != hipSuccess) fprintf(stderr, "kernel_launch: cooperative launch failed: %s (grid %d)\n", hipGetErrorString(e), grid);
    } else {
        for (int ph = 0; ph < NPHASE; ++ph) { a.ph_lo = ph; a.ph_hi = ph + 1; hipLaunchKernelGGL(fwd_kernel, dim3(grid), dim3(NT_BLK), LDS_BYTES, stream, a); }
    }
}
```
